# Optimizing an MI355X kernel written in HIP

```python
import math
import jax, jax.numpy as jnp
from jax import lax
import numpy as np


D_MODEL = 1024
BATCH = 8
SEQ = 4096
DEPTH = 1

CHUNK = 64
Q_BLOCK = 128
D_CONV = 512
CONV_K = 3
N_HEADS = 4
HEAD_DIM = 64
V_HEAD_DIM = 2 * HEAD_DIM
ATTN_QK = N_HEADS * 2 * HEAD_DIM
ATTN_V = N_HEADS * V_HEAD_DIM
D_FF = int(math.ceil(8 * D_MODEL / 3 / 256)) * 256
ROPE_THETA = 10000.0
EPS = 1e-6
SPLITS = (D_CONV, D_CONV, D_CONV, ATTN_QK, ATTN_QK, ATTN_V, D_MODEL, D_MODEL)
IN_COLS = sum(SPLITS)
SPLIT_IDX = [int(v) for v in np.cumsum(SPLITS)[:-1]]

kernel_name = "hybrid_shortconv_diffattn_block"


def _rmsnorm(x, g):
    xf = x.astype(jnp.float32)
    y = xf * lax.rsqrt(jnp.mean(xf * xf, axis=-1, keepdims=True) + EPS)
    return (y * g.astype(jnp.float32)).astype(x.dtype)


def _rope_tables(seq):
    pos = jnp.arange(seq, dtype=jnp.float32)
    inv = 1.0 / (ROPE_THETA ** (jnp.arange(0, HEAD_DIM, 2, dtype=jnp.float32) / HEAD_DIM))
    ang = pos[:, None] * inv[None, :]
    ang = jnp.concatenate([ang, ang], axis=-1)
    return jnp.cos(ang), jnp.sin(ang)


def _apply_rope(x, cos, sin):
    xf = x.astype(jnp.float32)
    x1, x2 = jnp.split(xf, 2, axis=-1)
    rot = jnp.concatenate([-x2, x1], axis=-1)
    c = cos[:, None, None, :]
    s = sin[:, None, None, :]
    return (xf * c + rot * s).astype(x.dtype)


def _short_conv_mixer(b_gate, c_gate, v, conv_w):
    u = c_gate * v
    y = lax.conv_general_dilated(
        u, conv_w[:, None, :].astype(u.dtype), window_strides=(1,),
        padding=[(CONV_K - 1, 0)], dimension_numbers=('NWC', 'WIO', 'NWC'),
        feature_group_count=D_CONV)
    return b_gate * y


def _diff_attention(q, k, v, q_norm, k_norm, lq1, lk1, lq2, lk2, sub_norm, lam_init, cos, sin):
    B, S = q.shape[0], q.shape[1]
    q = q.reshape(B, S, N_HEADS, 2, HEAD_DIM)
    k = k.reshape(B, S, N_HEADS, 2, HEAD_DIM)
    q = _apply_rope(_rmsnorm(q, q_norm), cos, sin)
    k = _apply_rope(_rmsnorm(k, k_norm), cos, sin)
    f32 = jnp.float32
    lam = (jnp.exp(jnp.sum(lq1.astype(f32) * lk1.astype(f32)))
           - jnp.exp(jnp.sum(lq2.astype(f32) * lk2.astype(f32))) + lam_init)
    q = q.transpose(3, 0, 2, 1, 4)
    k = k.transpose(3, 0, 2, 1, 4)
    vh = v.reshape(B, S, N_HEADS, V_HEAD_DIM).transpose(0, 2, 1, 3)
    nb = S // Q_BLOCK
    qb = q.reshape(2, B, N_HEADS, nb, Q_BLOCK, HEAD_DIM).transpose(3, 0, 1, 2, 4, 5)
    key_chunk = jnp.arange(S) // CHUNK
    scale = HEAD_DIM ** -0.5

    def block(args):
        qblk, i = args
        q_chunk = (i * Q_BLOCK + jnp.arange(Q_BLOCK)) // CHUNK
        mask = key_chunk[None, :] <= q_chunk[:, None]
        s = jnp.einsum('nbhqd,nbhkd->nbhqk', qblk, k).astype(f32) * scale
        p = jax.nn.softmax(jnp.where(mask, s, -jnp.inf), axis=-1)
        w = (p[0] - lam * p[1]).astype(vh.dtype)
        return jnp.einsum('bhqk,bhkd->bhqd', w, vh)

    o = lax.map(block, (qb, jnp.arange(nb)))
    o = o.transpose(1, 0, 3, 2, 4).reshape(B, S, N_HEADS, V_HEAD_DIM)
    o = _rmsnorm(o, sub_norm) * (1.0 - lam_init)
    return o.reshape(B, S, ATTN_V)


def setup_inputs(seed: int = 0) -> dict:
    key = jax.random.key(seed)
    ks = jax.random.split(key, 20)
    n = jax.random.normal
    f = jnp.float32
    L = DEPTH
    return {
        "x": n(ks[0], (BATCH, SEQ, D_MODEL), f),
        "g_mix": 1.0 + 0.02 * n(ks[1], (L, D_MODEL), f),
        "w_in": n(ks[2], (L, D_MODEL, IN_COLS), f) * D_MODEL ** -0.5,
        "b_gate": 0.02 * n(ks[3], (L, 2 * D_MODEL), f),
        "conv_w": n(ks[4], (L, CONV_K, D_CONV), f) * CONV_K ** -0.5,
        "q_norm": 1.0 + 0.02 * n(ks[5], (L, HEAD_DIM), f),
        "k_norm": 1.0 + 0.02 * n(ks[6], (L, HEAD_DIM), f),
        "lambda_q1": 0.1 * n(ks[7], (L, HEAD_DIM), f),
        "lambda_k1": 0.1 * n(ks[8], (L, HEAD_DIM), f),
        "lambda_q2": 0.1 * n(ks[9], (L, HEAD_DIM), f),
        "lambda_k2": 0.1 * n(ks[10], (L, HEAD_DIM), f),
        "sub_norm": 1.0 + 0.02 * n(ks[11], (L, V_HEAD_DIM), f),
        "w_conv_out": n(ks[12], (L, D_CONV, D_MODEL), f) * D_CONV ** -0.5,
        "w_attn_out": n(ks[13], (L, ATTN_V, D_MODEL), f) * ATTN_V ** -0.5,
        "w_o": n(ks[14], (L, D_MODEL, D_MODEL), f) * D_MODEL ** -0.5,
        "g_ffn": 1.0 + 0.02 * n(ks[15], (L, D_MODEL), f),
        "w_gate_up": n(ks[16], (L, D_MODEL, 2 * D_FF), f) * D_MODEL ** -0.5,
        "w_down": n(ks[17], (L, D_FF, D_MODEL), f) * D_FF ** -0.5,
    }


def reference(x, g_mix, w_in, b_gate, conv_w, q_norm, k_norm, lambda_q1, lambda_k1,
              lambda_q2, lambda_k2, sub_norm, w_conv_out, w_attn_out, w_o, g_ffn,
              w_gate_up, w_down):
    S = x.shape[1]
    cos, sin = _rope_tables(S)
    for l in range(DEPTH):
        lam_init = 0.8 - 0.6 * math.exp(-0.3 * l)
        h = _rmsnorm(x, g_mix[l])
        z = jnp.einsum('bsd,dc->bsc', h, w_in[l])
        bc, cc, vc, q, k, va, gc_pre, ga_pre = jnp.split(z, SPLIT_IDX, axis=-1)
        g_c = jax.nn.sigmoid(gc_pre + b_gate[l][:D_MODEL])
        g_a = jax.nn.sigmoid(ga_pre + b_gate[l][D_MODEL:])
        y_c = _short_conv_mixer(bc, cc, vc, conv_w[l]) @ w_conv_out[l]
        y_a = _diff_attention(q, k, va, q_norm[l], k_norm[l], lambda_q1[l], lambda_k1[l],
                              lambda_q2[l], lambda_k2[l], sub_norm[l], lam_init, cos, sin) @ w_attn_out[l]
        x = x + (g_c * y_c + g_a * y_a) @ w_o[l]
        h2 = _rmsnorm(x, g_ffn[l])
        gt, up = jnp.split(h2 @ w_gate_up[l], 2, axis=-1)
        x = x + (jax.nn.silu(gt) * up) @ w_down[l]
    return x
```

```cpp
#include <hip/hip_runtime.h>
#include <hip/hip_cooperative_groups.h>
#include <cstdio>
#include <cstdint>
namespace cg = cooperative_groups;

namespace pg8 {
#define PG8_LAS __attribute__((address_space(3)))
typedef unsigned short bf16_t;
typedef short bf16x8 __attribute__((ext_vector_type(8)));
typedef float f32x4 __attribute__((ext_vector_type(4)));
typedef unsigned u32x4 __attribute__((ext_vector_type(4)));
typedef unsigned u32x2 __attribute__((ext_vector_type(2)));
constexpr int BM = 256, BK = 64, HALF = 128, HTB = HALF * BK * 2  , STAGE_BYTES = 8 * HTB, NXCD = 8, WGM = 8;

__host__ __device__ __forceinline__ int lds_byte(int r, int c) { const int st = (r >> 4) * 2 + (c >> 5), rr = r & 15, cc = c & 31, ob = rr * 64 + cc * 2; return st * 1024 + (ob ^ (((ob >> 9) & 1) << 5)); }
__host__ __device__ __forceinline__ void stage_rc(int b, int& R, int& C) { const int st = b / 1024, sb = b % 1024, swz = sb ^ (((sb >> 9) & 1) << 5); R = (st >> 1) * 16 + swz / 64; C = (st & 1) * 32 + (swz % 64) / 2; }
__host__ __device__ __forceinline__ int perm32(int rho) { const int n = rho >> 4, i = rho & 15; return 8 * (i >> 2) + 4 * n + (i & 3); }

struct Unit { int pm, pn, seg; };
struct Gemm { const bf16_t* A0; const bf16_t* A1; const bf16_t* B0; const bf16_t* B1; int M, N, K; };

struct StaticOrder {
    int nM, nN, nwg, G, c, rep;
    __host__ __device__ void init(int M, int N, int G_, int c_, int rep_ = 1) { nM = M / BM; nN = N / BM; nwg = nM * nN; G = G_; c = c_; rep = rep_; }
    __host__ __device__ bool next(int i, Unit& u) const {
        long L = (long)i * G + c; if (L >= (long)nwg * rep) return false; L %= nwg;
        int wgid = (int)L; { const int q = nwg / NXCD, r = nwg % NXCD, xcd = wgid % NXCD, off = wgid / NXCD; wgid = (xcd < r ? xcd * (q + 1) : r * (q + 1) + (xcd - r) * q) + off; }
        const int nig = WGM * nN, gid = wgid / nig, fm = gid * WGM, gsz = (nM - fm) < WGM ? (nM - fm) : WGM;
        u.pm = fm + ((wgid % nig) % gsz); u.pn = (wgid % nig) / gsz; u.seg = 0; return true;
    }
    __device__ __forceinline__ void a_ready(const Unit&) const {}
    __device__ __forceinline__ void done(const Unit&) const {}
};
struct DualOrder {
    StaticOrder so;
    __host__ __device__ void init(int M, int N, int G_, int c_, int rep_ = 1) { so.init(M, N, G_, c_, rep_); }
    __host__ __device__ bool next(int i, Unit& u) const { if (!so.next(i >> 1, u)) return false; u.seg = i & 1; return true; }
    __device__ __forceinline__ void a_ready(const Unit&) const {}
    __device__ __forceinline__ void done(const Unit&) const {}
};

typedef float f32x2v_ __attribute__((ext_vector_type(2))); typedef __bf16 bf16x2v_ __attribute__((ext_vector_type(2)));
__device__ __forceinline__ unsigned cvt_pk_bf16(float lo, float hi) { f32x2v_ v = {lo, hi}; bf16x2v_ b = __builtin_convertvector(v, bf16x2v_); return __builtin_bit_cast(unsigned, b); }
__device__ __forceinline__ void store8(bf16_t* p, f32x4 a, f32x4 b) { u32x4 w; w.x = cvt_pk_bf16(a[0], a[1]); w.y = cvt_pk_bf16(a[2], a[3]); w.z = cvt_pk_bf16(b[0], b[1]); w.w = cvt_pk_bf16(b[2], b[3]); *(u32x4*)p = w; }
__device__ __forceinline__ void store8nt(bf16_t* p, f32x4 a, f32x4 b) { u32x4 w; w.x = cvt_pk_bf16(a[0], a[1]); w.y = cvt_pk_bf16(a[2], a[3]); w.z = cvt_pk_bf16(b[0], b[1]); w.w = cvt_pk_bf16(b[2], b[3]); __builtin_nontemporal_store(w, (u32x4*)p); }
__device__ __forceinline__ void load8(const bf16_t* p, f32x4& a, f32x4& b) { const u32x4 w = *(const u32x4*)p;
    a[0] = __uint_as_float(w.x << 16); a[1] = __uint_as_float(w.x & 0xffff0000u); a[2] = __uint_as_float(w.y << 16); a[3] = __uint_as_float(w.y & 0xffff0000u);
    b[0] = __uint_as_float(w.z << 16); b[1] = __uint_as_float(w.z & 0xffff0000u); b[2] = __uint_as_float(w.w << 16); b[3] = __uint_as_float(w.w & 0xffff0000u); }
__device__ __forceinline__ void load8nt(const bf16_t* p, f32x4& a, f32x4& b) { const u32x4 w = __builtin_nontemporal_load((const u32x4*)p);
    a[0] = __uint_as_float(w.x << 16); a[1] = __uint_as_float(w.x & 0xffff0000u); a[2] = __uint_as_float(w.y << 16); a[3] = __uint_as_float(w.y & 0xffff0000u);
    b[0] = __uint_as_float(w.z << 16); b[1] = __uint_as_float(w.z & 0xffff0000u); b[2] = __uint_as_float(w.w << 16); b[3] = __uint_as_float(w.w & 0xffff0000u); }
__device__ __forceinline__ float sigmoidf_(float x) { return __builtin_amdgcn_rcpf(1.0f + __builtin_amdgcn_exp2f(-1.4426950408889634f * x)); }
__device__ __forceinline__ f32x4 sigmoid4(f32x4 x) { f32x4 r; r[0] = sigmoidf_(x[0]); r[1] = sigmoidf_(x[1]); r[2] = sigmoidf_(x[2]); r[3] = sigmoidf_(x[3]); return r; }

constexpr float QK_C2 = 0.125f * 1.4426950408889634f;
constexpr float NORM_EPS = 1e-6f;

struct EpiInProj {
    static constexpr bool PERM = true, AFTER_DRAIN = false, KEEP = false;
    bf16_t *BC, *U, *Q, *Kb, *V, *G; const float* bgate; const float* qn; const float* kn; const float* costab; const float* sintab;
    __device__ __forceinline__ void operator()(const f32x4 (&acc)[2][2][4][2], const Unit& u, int wr, int wc, int fr, int fq) const {
        const int row0 = u.pm * BM + wr * 64 + fr, pn = u.pn, c8 = wc * 32 + 8 * fq;
        if (pn < 2 || (pn >= 10 && pn < 12)) {
            bf16_t* base = (pn < 2) ? (BC + pn * 256) : (V + (pn - 10) * 256);
#pragma unroll
            for (int ai = 0; ai < 2; ++ai)
#pragma unroll
                for (int m = 0; m < 4; ++m) { const int row = row0 + ai * HALF + m * 16; bf16_t* rp = base + (size_t)row * 512 + c8;
#pragma unroll
                    for (int bj = 0; bj < 2; ++bj) store8(rp + bj * HALF, acc[ai][bj][m][0], acc[ai][bj][m][1]); }
        } else if (pn < 6) {
            bf16_t* base = U + (pn - 2) * 128;
#pragma unroll
            for (int ai = 0; ai < 2; ++ai)
#pragma unroll
                for (int m = 0; m < 4; ++m) { const int row = row0 + ai * HALF + m * 16;
                    store8(base + (size_t)row * 512 + c8, acc[ai][0][m][0] * acc[ai][1][m][0], acc[ai][0][m][1] * acc[ai][1][m][1]); }
        } else if (pn < 10) {
            const bool isq = pn < 8; bf16_t* base = (isq ? (Q + (pn - 6) * 256) : (Kb + (pn - 8) * 256)) + wc * 64 + 8 * fq; const float* g = isq ? qn : kn; const float sc = isq ? QK_C2 : 1.0f;
            f32x4 gw[2][2];
#pragma unroll
            for (int bj = 0; bj < 2; ++bj)
#pragma unroll
                for (int n = 0; n < 2; ++n) gw[bj][n] = *(const f32x4*)(g + 32 * bj + 8 * fq + 4 * n);
#pragma unroll
            for (int ai = 0; ai < 2; ++ai)
#pragma unroll
                for (int m = 0; m < 4; ++m) { const int row = row0 + ai * HALF + m * 16;
                    float ss = 0.f;
#pragma unroll
                    for (int bj = 0; bj < 2; ++bj)
#pragma unroll
                        for (int n = 0; n < 2; ++n) { const f32x4 q = acc[ai][bj][m][n] * acc[ai][bj][m][n]; ss += (q[0] + q[1]) + (q[2] + q[3]); }
                    ss += __shfl_xor(ss, 16); ss += __shfl_xor(ss, 32);
                    const float rn = __builtin_amdgcn_rsqf(ss * (1.0f / 64.0f) + NORM_EPS) * sc;
                    const int pos = row & 4095; f32x4 o0[2], o1[2];
#pragma unroll
                    for (int n = 0; n < 2; ++n) { const u32x4 tw = *(const u32x4*)((const unsigned*)costab + pos * 32 + 8 * fq + 4 * n); f32x4 cv, sv;
#pragma unroll
                        for (int e = 0; e < 4; ++e) { cv[e] = __uint_as_float(tw[e] << 16); sv[e] = __uint_as_float(tw[e] & 0xffff0000u); }
                        const f32x4 a = acc[ai][0][m][n] * gw[0][n] * rn, b = acc[ai][1][m][n] * gw[1][n] * rn; o0[n] = a * cv - b * sv; o1[n] = b * cv + a * sv; }
                    bf16_t* rp = base + (size_t)row * 512; store8(rp, o0[0], o0[1]); store8(rp + 32, o1[0], o1[1]); }
        } else {
            const int gcol = (pn - 12) * 128 + c8; f32x4 bv[2][2];
#pragma unroll
            for (int bj = 0; bj < 2; ++bj)
#pragma unroll
                for (int n = 0; n < 2; ++n) bv[bj][n] = *(const f32x4*)(bgate + bj * 1024 + gcol + 4 * n);
#pragma unroll
            for (int ai = 0; ai < 2; ++ai)
#pragma unroll
                for (int m = 0; m < 4; ++m) { const int row = row0 + ai * HALF + m * 16; bf16_t* rp = G + (size_t)row * 2048 + gcol; f32x4 r[2], ga[2];
#pragma unroll
                    for (int n = 0; n < 2; ++n)
#pragma unroll
                        for (int e = 0; e < 4; ++e) { const float ec = 1.0f + __builtin_amdgcn_exp2f(-1.4426950408889634f * (acc[ai][0][m][n][e] + bv[0][n][e])), ea = 1.0f + __builtin_amdgcn_exp2f(-1.4426950408889634f * (acc[ai][1][m][n][e] + bv[1][n][e]));
                            r[n][e] = ea * __builtin_amdgcn_rcpf(ec); ga[n][e] = __builtin_amdgcn_rcpf(ea); }
                    store8nt(rp, r[0], r[1]); store8nt(rp + 1024, ga[0], ga[1]); }
        }
    }
};
struct EpiDual {
    static constexpr bool PERM = true, AFTER_DRAIN = false, KEEP = true;
    const bf16_t* G; bf16_t* M1;
    __device__ __forceinline__ void operator()(f32x4 (&acc)[2][2][4][2], const Unit& u, int wr, int wc, int fr, int fq) const {
        const int row0 = u.pm * BM + wr * 64 + fr, col0 = u.pn * BM + wc * 32 + 8 * fq;
        if (u.seg == 0) {
#pragma unroll
            for (int ai = 0; ai < 2; ++ai)
#pragma unroll
                for (int m = 0; m < 4; ++m) { const int row = row0 + ai * HALF + m * 16; const bf16_t* gp = G + (size_t)row * 2048 + col0;
#pragma unroll
                    for (int bj = 0; bj < 2; ++bj) { f32x4 c0, c1; load8nt(gp + bj * HALF, c0, c1); acc[ai][bj][m][0] *= c0; acc[ai][bj][m][1] *= c1; } }
        } else {
#pragma unroll
            for (int ai = 0; ai < 2; ++ai)
#pragma unroll
                for (int m = 0; m < 4; ++m) { const int row = row0 + ai * HALF + m * 16; const bf16_t* gp = G + (size_t)row * 2048 + 1024 + col0; bf16_t* mp = M1 + (size_t)row * 1024 + col0;
#pragma unroll
                    for (int bj = 0; bj < 2; ++bj) { f32x4 a0, a1; load8nt(gp + bj * HALF, a0, a1); store8(mp + bj * HALF, a0 * acc[ai][bj][m][0], a1 * acc[ai][bj][m][1]); } }
        }
    }
};
struct EpiX1 {
    static constexpr bool PERM = true, AFTER_DRAIN = false, KEEP = false;
    bf16_t* X1B; const float* irs; float* SS;
    __device__ __forceinline__ void operator()(const f32x4 (&acc)[2][2][4][2], const Unit& u, int wr, int wc, int fr, int fq) const {
        const int row0 = u.pm * BM + wr * 64 + fr, col0 = u.pn * BM + wc * 32 + 8 * fq, lane = 16 * fq + fr;
        float irl[2];
#pragma unroll
        for (int ai = 0; ai < 2; ++ai) irl[ai] = irs[u.pm * BM + ai * HALF + wr * 64 + lane];
#pragma unroll
        for (int ai = 0; ai < 2; ++ai)
#pragma unroll
            for (int m = 0; m < 4; ++m) { const int row = row0 + ai * HALF + m * 16; bf16_t* xp = X1B + (size_t)row * 1024 + col0; const float ir = __shfl(irl[ai], 16 * m + fr); float ss = 0.f;
#pragma unroll
                for (int bj = 0; bj < 2; ++bj) { f32x4 x0, x1; load8nt(xp + bj * HALF, x0, x1); const f32x4 v0 = x0 * ir + acc[ai][bj][m][0], v1 = x1 * ir + acc[ai][bj][m][1];
                    store8(xp + bj * HALF, v0, v1); const f32x4 q = v0 * v0 + v1 * v1; ss += (q[0] + q[1]) + (q[2] + q[3]); }
                ss += __shfl_xor(ss, 16); ss += __shfl_xor(ss, 32);
                if (fq == 0) unsafeAtomicAdd(SS + row, ss); }
    }
};
struct EpiGateUp {
    static constexpr bool PERM = true, AFTER_DRAIN = false, KEEP = false;
    const float* SS; bf16_t* ACT;
    __device__ __forceinline__ void operator()(const f32x4 (&acc)[2][2][4][2], const Unit& u, int wr, int wc, int fr, int fq) const {
        const int row0 = u.pm * BM + wr * 64 + fr, col0 = u.pn * 128 + wc * 32 + 8 * fq, lane = 16 * fq + fr;
        float rsl[2];
#pragma unroll
        for (int ai = 0; ai < 2; ++ai) rsl[ai] = __builtin_amdgcn_rsqf(SS[u.pm * BM + ai * HALF + wr * 64 + lane] * (1.0f / 1024.0f) + NORM_EPS);
#pragma unroll
        for (int ai = 0; ai < 2; ++ai)
#pragma unroll
            for (int m = 0; m < 4; ++m) { const int row = row0 + ai * HALF + m * 16; const float rs = __shfl(rsl[ai], 16 * m + fr);
                f32x4 a[2];
#pragma unroll
                for (int n = 0; n < 2; ++n) { const f32x4 g = acc[ai][0][m][n] * rs, up = acc[ai][1][m][n] * rs; a[n] = g * sigmoid4(g) * up; }
                store8(ACT + (size_t)row * 2816 + col0, a[0], a[1]); }
    }
};
struct EpiDown {
    static constexpr bool PERM = true, AFTER_DRAIN = false, KEEP = false;
    const bf16_t* X1B; float* out;
    __device__ __forceinline__ void operator()(const f32x4 (&acc)[2][2][4][2], const Unit& u, int wr, int wc, int fr, int fq) const {
        const int row0 = u.pm * BM + wr * 64 + fr, col0 = u.pn * BM + wc * 32 + 8 * fq;
#pragma unroll
        for (int ai = 0; ai < 2; ++ai)
#pragma unroll
            for (int m = 0; m < 4; ++m) { const size_t off = (size_t)(row0 + ai * HALF + m * 16) * 1024 + col0;
#pragma unroll
                for (int bj = 0; bj < 2; ++bj) { f32x4 x0, x1; load8nt(X1B + off + bj * HALF, x0, x1); float* op = out + off + bj * HALF;
                    __builtin_nontemporal_store(x0 + acc[ai][bj][m][0], (f32x4*)op); __builtin_nontemporal_store(x1 + acc[ai][bj][m][1], (f32x4*)(op + 4)); } }
    }
};

template <class Epi, class Sched, bool ALIGN_EPI = false, bool SP2 = false>
__device__ __forceinline__ void gemm_phase(PG8_LAS unsigned char* lds, const Gemm g, const Sched& S, const Epi& E) {
    const int tid = threadIdx.x, wid = __builtin_amdgcn_readfirstlane(tid >> 6), lane = tid & 63, wr = wid >> 2, wc = wid & 3, fr = lane & 15, fq = lane >> 4;
    const int K = g.K, nt = K / BK;
    unsigned voffA[2], voffB[2];
#pragma unroll
    for (int i = 0; i < 2; ++i) { int R, C; stage_rc(tid * 16 + i * 8192, R, C); const int Rb = Epi::PERM ? ((R & ~31) + perm32(R & 31)) : R;
        voffA[i] = (unsigned)(R * K + C) * 2u; voffB[i] = (unsigned)(Rb * K + C) * 2u; }
    const size_t kstep = (size_t)(BK * 2);
    const size_t hstep = (size_t)HALF * K * 2;
    const size_t tstep = 2 * hstep;
    const unsigned ldsw = (unsigned)wid * 1024u;
    const int aoff = lds_byte(wr * 64 + fr, fq * 8), boff = lds_byte(wc * 32 + fr, fq * 8);
#define PG8_SA(b, h) (((b) * 2 + (h)) * HTB)
#define PG8_SB(b, h) ((4 + (b) * 2 + (h)) * HTB)
#define PG8_STAGE(bufoff, gbase, voff) do { _Pragma("unroll") for (int _i = 0; _i < 2; ++_i) \
        __builtin_amdgcn_global_load_lds((const unsigned*)((const char*)(gbase) + (voff)[_i]), (PG8_LAS unsigned*)(lds + (bufoff) + ldsw + _i * 8192), 16, 0, 0); } while (0)
#define PG8_LDA(dst, b, h) do { _Pragma("unroll") for (int m = 0; m < 4; ++m) _Pragma("unroll") for (int k = 0; k < 2; ++k) dst[m][k] = *(const PG8_LAS bf16x8*)(lds + PG8_SA(b, h) + aoff + m * 2048 + k * 1024); } while (0)
#define PG8_LDB(dst, b, h) do { _Pragma("unroll") for (int n = 0; n < 2; ++n) _Pragma("unroll") for (int k = 0; k < 2; ++k) dst[n][k] = *(const PG8_LAS bf16x8*)(lds + PG8_SB(b, h) + boff + n * 2048 + k * 1024); } while (0)
#define PG8_MMA(ai, bj, At, Bt) do { __builtin_amdgcn_s_setprio(1); _Pragma("unroll") for (int m = 0; m < 4; ++m) _Pragma("unroll") for (int n = 0; n < 2; ++n) _Pragma("unroll") for (int k = 0; k < 2; ++k) \
        acc[ai][bj][m][n] = __builtin_amdgcn_mfma_f32_16x16x32_bf16(Bt[n][k], At[m][k], acc[ai][bj][m][n], 0, 0, 0); __builtin_amdgcn_s_setprio(0); } while (0)
#define PG8_WAIT_V(n) asm volatile("s_waitcnt vmcnt(" #n ")" ::: "memory")
#define PG8_WAIT_L(n) asm volatile("s_waitcnt lgkmcnt(" #n ")" ::: "memory")
#define PG8_BAR __builtin_amdgcn_s_barrier()
#define PG8_SCHED __builtin_amdgcn_sched_barrier(0)
    Unit cur, nxt; int ui = 0;
    if (!S.next(0, cur)) return;
    f32x4 acc[2][2][4][2];
#pragma unroll
    for (int a = 0; a < 2; ++a)
#pragma unroll
        for (int b = 0; b < 2; ++b)
#pragma unroll
            for (int m = 0; m < 4; ++m)
#pragma unroll
                for (int n = 0; n < 2; ++n) acc[a][b][m][n] = (f32x4){0.f, 0.f, 0.f, 0.f};
    bf16x8 At[4][2], B0[2][2], B1[2][2];
    const char* cA = (const char*)(cur.seg ? g.A1 : g.A0) + (size_t)cur.pm * tstep; const char* cB = (const char*)(cur.seg ? g.B1 : g.B0) + (size_t)cur.pn * tstep;
    S.a_ready(cur);
    if constexpr (SP2) {
        PG8_STAGE(PG8_SB(0, 0), cB, voffB); PG8_STAGE(PG8_SB(0, 1), cB + hstep, voffB); PG8_STAGE(PG8_SA(0, 0), cA, voffA); PG8_STAGE(PG8_SA(0, 1), cA + hstep, voffA);
        if (wr == 1) PG8_BAR;
        PG8_WAIT_V(2); PG8_BAR;
        PG8_STAGE(PG8_SB(1, 0), cB + kstep, voffB); PG8_STAGE(PG8_SA(1, 0), cA + kstep, voffA); PG8_STAGE(PG8_SB(1, 1), cB + hstep + kstep, voffB);
        PG8_WAIT_V(6); PG8_BAR;
    } else {
        PG8_STAGE(PG8_SB(0, 0), cB, voffB); PG8_STAGE(PG8_SA(0, 0), cA, voffA); PG8_STAGE(PG8_SB(0, 1), cB + hstep, voffB); PG8_STAGE(PG8_SA(0, 1), cA + hstep, voffA);
        if (wr == 1) PG8_BAR;
        PG8_WAIT_V(4); PG8_BAR;
        PG8_STAGE(PG8_SB(1, 0), cB + kstep, voffB); PG8_STAGE(PG8_SA(1, 0), cA + kstep, voffA); PG8_STAGE(PG8_SB(1, 1), cB + hstep + kstep, voffB);
        PG8_WAIT_V(6); PG8_BAR;
    }
    for (;;) {
        const bool has_next = S.next(ui + 1, nxt);
        const char* nA = has_next ? (const char*)(nxt.seg ? g.A1 : g.A0) + (size_t)nxt.pm * tstep : cA; const char* nB = has_next ? (const char*)(nxt.seg ? g.B1 : g.B0) + (size_t)nxt.pn * tstep : cB;
        for (int t = 0; t < nt; t += 2) {
            const bool last = (t == nt - 2);
            const char* a1 = cA + (size_t)(t + 1) * kstep;
            const char* a2 = last ? nA : cA + (size_t)(t + 2) * kstep; const char* b2 = last ? nB : cB + (size_t)(t + 2) * kstep;
            const char* a3 = a2 + kstep; const char* b3 = b2 + kstep;
            if (last && has_next) S.a_ready(nxt);
            if constexpr (SP2) {
            PG8_LDB(B0, 0, 0); PG8_LDB(B1, 0, 1); PG8_SCHED; PG8_LDA(At, 0, 0); PG8_STAGE(PG8_SA(1, 1), a1 + hstep, voffA);
            PG8_WAIT_V(8); PG8_WAIT_L(0); PG8_BAR; PG8_MMA(0, 0, At, B0); PG8_MMA(0, 1, At, B1); PG8_BAR; PG8_SCHED;
            PG8_LDA(At, 0, 1); PG8_STAGE(PG8_SB(0, 0), b2, voffB); PG8_STAGE(PG8_SB(0, 1), b2 + hstep, voffB); PG8_STAGE(PG8_SA(0, 0), a2, voffA);
            PG8_WAIT_V(8); PG8_WAIT_L(0); PG8_BAR; PG8_MMA(1, 0, At, B0); PG8_MMA(1, 1, At, B1); PG8_BAR; PG8_SCHED;
            PG8_LDB(B0, 1, 0); PG8_LDB(B1, 1, 1); PG8_SCHED; PG8_LDA(At, 1, 0); PG8_STAGE(PG8_SA(0, 1), a2 + hstep, voffA);
            PG8_WAIT_V(8); PG8_WAIT_L(0); PG8_BAR; PG8_MMA(0, 0, At, B0); PG8_MMA(0, 1, At, B1); PG8_BAR; PG8_SCHED;
            PG8_LDA(At, 1, 1); PG8_STAGE(PG8_SB(1, 0), b3, voffB); PG8_STAGE(PG8_SB(1, 1), b3 + hstep, voffB); PG8_STAGE(PG8_SA(1, 0), a3, voffA);
            PG8_WAIT_V(8); PG8_WAIT_L(0); PG8_BAR; PG8_MMA(1, 0, At, B0); PG8_MMA(1, 1, At, B1); PG8_BAR; PG8_SCHED;
            } else {
            PG8_LDB(B0, 0, 0); PG8_SCHED; PG8_LDA(At, 0, 0); PG8_STAGE(PG8_SA(1, 1), a1 + hstep, voffA);
            PG8_WAIT_L(8); PG8_BAR; PG8_WAIT_L(0); PG8_MMA(0, 0, At, B0); PG8_BAR; PG8_SCHED;
            PG8_LDB(B1, 0, 1); PG8_STAGE(PG8_SB(0, 0), b2, voffB);
            PG8_BAR; PG8_WAIT_L(0); PG8_MMA(0, 1, At, B1); PG8_BAR;
            PG8_LDA(At, 0, 1); PG8_STAGE(PG8_SA(0, 0), a2, voffA);
            PG8_BAR; PG8_WAIT_L(0); PG8_MMA(1, 0, At, B0); PG8_BAR; PG8_SCHED;
            PG8_STAGE(PG8_SB(0, 1), b2 + hstep, voffB);
            PG8_WAIT_V(6); PG8_BAR; PG8_MMA(1, 1, At, B1); PG8_BAR;
            PG8_LDB(B0, 1, 0); PG8_SCHED; PG8_LDA(At, 1, 0); PG8_STAGE(PG8_SA(0, 1), a2 + hstep, voffA);
            PG8_WAIT_L(8); PG8_BAR; PG8_WAIT_L(0); PG8_MMA(0, 0, At, B0); PG8_BAR; PG8_SCHED;
            PG8_LDB(B1, 1, 1); PG8_STAGE(PG8_SB(1, 0), b3, voffB);
            PG8_BAR; PG8_WAIT_L(0); PG8_MMA(0, 1, At, B1); PG8_BAR;
            PG8_LDA(At, 1, 1); PG8_STAGE(PG8_SA(1, 0), a3, voffA);
            PG8_BAR; PG8_WAIT_L(0); PG8_MMA(1, 0, At, B0); PG8_BAR; PG8_SCHED;
            PG8_STAGE(PG8_SB(1, 1), b3 + hstep, voffB);
            PG8_WAIT_V(6); PG8_BAR; PG8_MMA(1, 1, At, B1); PG8_BAR;
            }
        }
        if constexpr (ALIGN_EPI) { if (wr == 0) PG8_BAR; }
        if constexpr (!Epi::AFTER_DRAIN) { E(acc, cur, wr, wc, fr, fq); S.done(cur); }
        if (!has_next) break;
        if (!(Epi::KEEP && cur.seg == 0)) {
#pragma unroll
        for (int a = 0; a < 2; ++a)
#pragma unroll
            for (int b = 0; b < 2; ++b)
#pragma unroll
                for (int m = 0; m < 4; ++m)
#pragma unroll
                    for (int n = 0; n < 2; ++n) acc[a][b][m][n] = (f32x4){0.f, 0.f, 0.f, 0.f};
        }
        cur = nxt; cA = nA; cB = nB; ++ui;
        if constexpr (ALIGN_EPI) { if (wr == 1) PG8_BAR; }
    }
    PG8_WAIT_V(0);
    if constexpr (!ALIGN_EPI) { if (wr == 0) PG8_BAR; }
    PG8_BAR;
    if constexpr (Epi::AFTER_DRAIN) { E.fused(acc, cur, wr, wc, fr, fq, lds, wid, lane); S.done(cur); }
#undef PG8_SA
#undef PG8_SB
#undef PG8_STAGE
#undef PG8_LDA
#undef PG8_LDB
#undef PG8_MMA
#undef PG8_WAIT_V
#undef PG8_WAIT_L
#undef PG8_BAR
#undef PG8_SCHED
}
}


namespace att {
#define ATT_LAS __attribute__((address_space(3)))
typedef unsigned short bf16_t;
typedef short bf16x8 __attribute__((ext_vector_type(8)));
typedef short s16x4 __attribute__((ext_vector_type(4)));
typedef float f32x16 __attribute__((ext_vector_type(16)));
typedef unsigned u32x4 __attribute__((ext_vector_type(4)));
typedef float f32x2_t __attribute__((ext_vector_type(2))); typedef __bf16 bf16x2_t __attribute__((ext_vector_type(2)));
constexpr int SEQ = 4096, PITCH = 512, NW = 8, QBLK = 32, QB = QBLK * NW, KVBLK = 64;
constexpr int NSLOT = 3, SLOTB = 32768, OFF_K1 = 8192, OFF_V = 16384, LDS_BYTES = NSLOT * SLOTB;
constexpr int QB2 = 128;
__device__ __forceinline__ int crow(int r, int hi) { return (r & 3) + 8 * (r >> 2) + 4 * hi; }
__device__ __forceinline__ void glds16(const void* gsrc, unsigned lds_dst) { unsigned keep;
    asm volatile("s_mov_b32 %0, m0\n\ts_mov_b32 m0, %2\n\ts_nop 0\n\tglobal_load_lds_dwordx4 %1, off\n\ts_mov_b32 m0, %0" : "=&s"(keep) : "v"(gsrc), "s"(lds_dst) : "memory"); }
__device__ __forceinline__ unsigned cvtpk_s(float lo, float hi) { f32x2_t v = {lo, hi}; bf16x2_t b = __builtin_convertvector(v, bf16x2_t); return __builtin_bit_cast(unsigned, b); }
typedef ATT_LAS const char* lds_cptr;
typedef short v4i16_t __attribute__((ext_vector_type(4)));
__device__ __forceinline__ s16x4 vtr(lds_cptr p) { return __builtin_bit_cast(s16x4, __builtin_amdgcn_ds_read_tr16_b64_v4i16((ATT_LAS v4i16_t*)p)); }
#define ATT_WAIT_BAR(N) asm volatile("s_waitcnt vmcnt(" #N ") lgkmcnt(0)\n\ts_barrier" ::: "memory")

__device__ __forceinline__ void attn_unit(const int b, const int h, const int qb, const bf16_t* Q, const bf16_t* K, const bf16_t* V, bf16_t* O, ATT_LAS char* shm, const float lam) {
    const int tid = threadIdx.x, lane = tid & 63, r32 = lane & 31, hi = lane >> 5; const int wid = __builtin_amdgcn_readfirstlane(tid >> 6), sub = wid >> 2, w4 = wid & 3;
    const long rowbase = (long)b * SEQ; const int q0 = qb * QB2;
    const bf16_t* Qw = Q + (rowbase + q0 + w4 * QBLK) * PITCH + h * 128 + sub * 64;
    const bf16_t* Kh = K + rowbase * PITCH + h * 128; const bf16_t* Vh = V + rowbase * PITCH + h * 128;
    const unsigned lds0 = (unsigned)(uintptr_t)shm;
    const bf16_t* ksrc = Kh + (long)lane * PITCH + wid * 8;
    const bf16_t* vsrc = Vh + (long)(16 * (wid & 3) + (lane >> 2)) * PITCH + (wid >> 2) * 32 + (lane & 3) * 8;
    const unsigned pdst = lds0 + wid * 1024;
#define DMA_T(t, s) do { const long go_ = (long)(t) * KVBLK * PITCH; const unsigned sd_ = (unsigned)__builtin_amdgcn_readfirstlane(pdst + (s) * SLOTB); \
        glds16(ksrc + go_, sd_); glds16(ksrc + go_ + 64, sd_ + OFF_K1); glds16(vsrc + go_, sd_ + OFF_V); glds16(vsrc + go_ + 64, sd_ + OFF_V + 8192); } while (0)
    const lds_cptr kp0 = (lds_cptr)shm + sub * OFF_K1 + hi * 1024 + r32 * 16;
    const lds_cptr vp0 = (lds_cptr)shm + OFF_V + ((lane >> 4) & 1) * 32 + (lane & 3) * 8 + (4 * hi + ((lane & 15) >> 2)) * 64;
    const int NT = (q0 + QB2) / KVBLK;
    const int mylast = q0 / KVBLK + (w4 >> 1);
    DMA_T(0, 0); DMA_T(1, 1);
    bf16x8 qr[4];
#pragma unroll
    for (int d0 = 0; d0 < 4; ++d0) qr[d0] = *reinterpret_cast<const bf16x8*>(&Qw[(long)r32 * PITCH + d0 * 16 + hi * 8]);
    asm volatile("" : "+v"(qr[0]), "+v"(qr[1]), "+v"(qr[2]), "+v"(qr[3]));
    f32x16 o[4]; o[0] = f32x16{}; o[1] = f32x16{}; o[2] = f32x16{}; o[3] = f32x16{};
    float l_reg = 0.f;
    int slot = 0, slot2 = 2;
    for (int t = 0; t < NT; ++t) {
        if (t + 1 < NT) { ATT_WAIT_BAR(4); } else { ATT_WAIT_BAR(0); }
        if (t + 2 < NT) DMA_T(t + 2, slot2);
        if (t <= mylast) {
            const lds_cptr kp = kp0 + slot * SLOTB; const lds_cptr vp = vp0 + slot * SLOTB;
#define ATT_SBAR() __builtin_amdgcn_sched_barrier(0)
#define ATT_VLOAD(dst, d0) do { _Pragma("unroll") for (int ks = 0; ks < 4; ++ks) { dst[2 * ks] = vtr(vp + (d0) * 4096 + ks * 1024); dst[2 * ks + 1] = vtr(vp + (d0) * 4096 + ks * 1024 + 512); } } while (0)
#define ATT_PV(acc, src) do { _Pragma("unroll") for (int ks = 0; ks < 4; ++ks) { const bf16x8 vf_ = (bf16x8){src[2 * ks][0], src[2 * ks][1], src[2 * ks][2], src[2 * ks][3], src[2 * ks + 1][0], src[2 * ks + 1][1], src[2 * ks + 1][2], src[2 * ks + 1][3]}; \
                acc = __builtin_amdgcn_mfma_f32_32x32x16_bf16(__builtin_bit_cast(bf16x8, pw[ks]), vf_, acc, 0, 0, 0); } } while (0)
            bf16x8 kf[8]; s16x4 va[8], vb[8];
#pragma unroll
            for (int d0 = 0; d0 < 4; ++d0) { kf[2 * d0] = *(const ATT_LAS bf16x8*)(kp + d0 * 2048); kf[2 * d0 + 1] = *(const ATT_LAS bf16x8*)(kp + d0 * 2048 + 512); }
            ATT_VLOAD(va, 0);
            ATT_SBAR();
            f32x16 p0 = f32x16{}, p1 = f32x16{};
#pragma unroll
            for (int d0 = 0; d0 < 4; ++d0) { p0 = __builtin_amdgcn_mfma_f32_32x32x16_bf16(kf[2 * d0], qr[d0], p0, 0, 0, 0); p1 = __builtin_amdgcn_mfma_f32_32x32x16_bf16(kf[2 * d0 + 1], qr[d0], p1, 0, 0, 0); }
            ATT_SBAR();
            ATT_VLOAD(vb, 1);
            ATT_SBAR();
#pragma unroll
            for (int r = 0; r < 16; ++r) { p0[r] = __builtin_amdgcn_exp2f(p0[r]); p1[r] = __builtin_amdgcn_exp2f(p1[r]); }
            u32x4 pw[4];
#pragma unroll
            for (int j = 0; j < 4; ++j) { pw[0][j] = cvtpk_s(p0[2 * j], p0[2 * j + 1]); pw[1][j] = cvtpk_s(p0[8 + 2 * j], p0[9 + 2 * j]); pw[2][j] = cvtpk_s(p1[2 * j], p1[2 * j + 1]); pw[3][j] = cvtpk_s(p1[8 + 2 * j], p1[9 + 2 * j]); }
            { float sa = 0.f, sb = 0.f;
#pragma unroll
              for (int r = 0; r < 16; ++r) { sa += p0[r]; sb += p1[r]; }
              l_reg += sa + sb; }
            ATT_PV(o[0], va);
            ATT_SBAR();
            ATT_VLOAD(va, 2);
            ATT_SBAR();
            ATT_PV(o[1], vb);
            ATT_SBAR();
            ATT_VLOAD(vb, 3);
            ATT_SBAR();
            ATT_PV(o[2], va);
            ATT_SBAR();
            ATT_PV(o[3], vb);
#undef ATT_SBAR
#undef ATT_VLOAD
#undef ATT_PV
        }
        slot = (slot == NSLOT - 1) ? 0 : slot + 1; slot2 = (slot2 == NSLOT - 1) ? 0 : slot2 + 1;
    }
#undef DMA_T
    { auto rr = __builtin_amdgcn_permlane32_swap(__float_as_uint(l_reg), __float_as_uint(l_reg), false, false); l_reg = __uint_as_float(rr[0]) + __uint_as_float(rr[1]); }
    const float rl = __builtin_amdgcn_rcpf(l_reg);
    asm volatile("s_waitcnt vmcnt(0) lgkmcnt(0)\n\ts_barrier" ::: "memory");
    ATT_LAS float* xa = (ATT_LAS float*)shm + w4 * 4096 + lane;
    if (sub == 0) {
#pragma unroll
        for (int r = 0; r < 16; ++r) { const float rli = __shfl(rl, crow(r, hi));
#pragma unroll
            for (int d0 = 0; d0 < 4; ++d0) xa[(d0 * 16 + r) * 64] = o[d0][r] * rli; }
    }
    asm volatile("s_waitcnt lgkmcnt(0)\n\ts_barrier" ::: "memory");
    if (sub == 1) {
        ATT_LAS bf16_t* stg = (ATT_LAS bf16_t*)(shm + 65536 + w4 * 8192);
#pragma unroll
        for (int r = 0; r < 16; ++r) { const int rw = crow(r, hi); const float rli = __shfl(rl, rw) * lam;
            float v[4]; float ss = 0.f;
#pragma unroll
            for (int d0 = 0; d0 < 4; ++d0) { v[d0] = xa[(d0 * 16 + r) * 64] - o[d0][r] * rli; ss += v[d0] * v[d0]; }
            ss += __shfl_xor(ss, 1); ss += __shfl_xor(ss, 2); ss += __shfl_xor(ss, 4); ss += __shfl_xor(ss, 8); ss += __shfl_xor(ss, 16);
            const float rn = __builtin_amdgcn_rsqf(ss * (1.0f / 128.0f) + 1e-6f);
#pragma unroll
            for (int d0 = 0; d0 < 4; ++d0) stg[rw * 128 + d0 * 32 + r32] = (bf16_t)(cvtpk_s(v[d0] * rn, 0.f) & 0xffffu); }
        asm volatile("s_waitcnt lgkmcnt(0)" ::: "memory");
        bf16_t* obase = O + (rowbase + q0 + w4 * QBLK) * PITCH + h * 128;
#pragma unroll
        for (int i = 0; i < 8; ++i) { const int row = i * 4 + (lane >> 4), ch = lane & 15; const u32x4 w = *(const ATT_LAS u32x4*)(stg + row * 128 + ch * 8); *(u32x4*)(obase + (long)row * PITCH + ch * 8) = w; }
    }
    asm volatile("s_waitcnt vmcnt(0) lgkmcnt(0)\n\ts_barrier" ::: "memory");
}
#undef ATT_WAIT_BAR
}

constexpr int NWAVES = 8;
#ifndef MK_N_LAUNCHES
#define MK_N_LAUNCHES 1
#endif
constexpr int N_PHASES = 7;
constexpr int BATCH = 8, SEQ = 4096, D = 1024, M = BATCH * SEQ, DC = 512, NQK = 512, NV = 512, INC = 5120, FF = 2816, FF2 = 5632;
constexpr size_t MiB = 1u << 20;
constexpr size_t WS_CTL = 0, CTL_ZERO_BYTES = 16384;
constexpr size_t WS_COS = 1 * MiB, WS_SIN = 1 * MiB + 512 * 1024, WS_RS1 = 2 * MiB, WS_SS = 3 * MiB;
constexpr size_t WS_WIN = 8 * MiB, WS_WGU = 18 * MiB, WS_WDN = 29 * MiB, WS_WO = 36 * MiB, WS_WC = 38 * MiB, WS_WA = 39 * MiB;
constexpr size_t WS_XB = 40 * MiB;
constexpr size_t WS_O0 = 40 * MiB, WS_X1B = 40 * MiB;
constexpr size_t WS_BC = 104 * MiB, WS_U = 136 * MiB;
constexpr size_t WS_M1 = 104 * MiB;
constexpr size_t WS_Q = 168 * MiB, WS_K = 200 * MiB, WS_V = 232 * MiB;
constexpr size_t WS_G = 264 * MiB;
constexpr size_t WS_CM = 392 * MiB, WS_O = 424 * MiB;
constexpr size_t WS_ACT = 104 * MiB;
constexpr size_t WS_END = 456 * MiB;
static_assert(WS_ACT + (size_t)M * FF * 2 <= WS_CM && WS_G + (size_t)M * 2048 * 2 <= WS_CM && WS_O + (size_t)M * 512 * 2 <= WS_END, "d_ws map");

constexpr int LDS_BYTES = 147456, MISC_OFF = 131072 + 8192;
#define GAS __attribute__((address_space(1)))
#define LAS __attribute__((address_space(3)))
typedef unsigned short bf16;
typedef unsigned v4u __attribute__((ext_vector_type(4)));
typedef float f32x4 __attribute__((ext_vector_type(4)));
#define LDS_WAIT() asm volatile("s_waitcnt lgkmcnt(0)" ::: "memory")
__device__ __forceinline__ unsigned f2bf(float f) { unsigned u = __builtin_bit_cast(unsigned, f); return (u + 0x7fffu + ((u >> 16) & 1u)) >> 16; }
__device__ __forceinline__ unsigned pk2(float lo, float hi) { return f2bf(lo) | (f2bf(hi) << 16); }
__device__ __forceinline__ float wave_sum(float v) {
#pragma unroll
    for (int o = 1; o < 64; o <<= 1) v += __shfl_xor(v, o);
    return v;
}
__device__ __forceinline__ float wave_max(float v) {
#pragma unroll
    for (int o = 1; o < 64; o <<= 1) v = fmaxf(v, __shfl_xor(v, o));
    return v;
}
__device__ __forceinline__ int dst_win(int n0) {
    if (n0 < 512) return n0;
    if (n0 < 1024) { const int ch = n0 - 512; return 512 + 256 * (ch >> 7) + (ch & 127); }
    if (n0 < 1536) { const int ch = n0 - 1024; return 512 + 256 * (ch >> 7) + 128 + (ch & 127); }
    if (n0 < 2560) { const int off = n0 - 1536, tile = off >> 8, w = off & 255, wc = w >> 6, bj = (w & 63) >> 5; return 1536 + 256 * tile + 128 * bj + 32 * wc; }
    if (n0 < 3072) return n0;
    if (n0 < 4096) { const int c = n0 - 3072; return 3072 + 256 * (c >> 7) + (c & 127); }
    { const int c = n0 - 4096; return 3072 + 256 * (c >> 7) + 128 + (c & 127); }
}
__device__ __forceinline__ int dst_wgu(int n0) { if (n0 < FF) return 256 * (n0 >> 7) + (n0 & 127); const int n = n0 - FF; return 256 * (n >> 7) + 128 + (n & 127); }
template <int MAP> __device__ __forceinline__ void p0_transpose_item(const float* W, int K, int N, bf16* WT, const float* kscale, int kmask, float cs, LAS float* scr, int item, int lane) {
    const int nblk = N / 32, kb = item / nblk, nb = item % nblk, k0 = 64 * kb, n0 = 32 * nb;
    const int d0 = (MAP == 1) ? dst_win(n0) : (MAP == 2) ? dst_wgu(n0) : n0;
#pragma unroll
    for (int i = 0; i < 32; ++i) { const int kk = 2 * i + (lane >> 5); const float s = kscale ? kscale[(k0 + kk) & kmask] * cs : cs; scr[kk * 33 + (lane & 31)] = __builtin_nontemporal_load(W + (size_t)(k0 + kk) * N + n0 + (lane & 31)) * s; }
    LDS_WAIT(); asm volatile("" ::: "memory");
    const int c = lane & 7;
#pragma unroll
    for (int j = 0; j < 4; ++j) { const int n = (lane >> 3) + 8 * j; const LAS float* s = scr + (8 * c) * 33 + n;
        v4u o; o.x = pk2(s[0 * 33], s[1 * 33]); o.y = pk2(s[2 * 33], s[3 * 33]); o.z = pk2(s[4 * 33], s[5 * 33]); o.w = pk2(s[6 * 33], s[7 * 33]);
        *(GAS v4u*)(WT + (size_t)(d0 + n) * K + k0 + 8 * c) = o; }
    LDS_WAIT(); asm volatile("" ::: "memory");
}

typedef GAS unsigned gu32;
#define XB_TMO      128
#define XB_XCNT(j)  (256  + 64 * (j))
#define XB_XSUB(j)  (1280 + 64 * (j))
#define XB_XGEN(j)  (2304 + 64 * (j))
#define XB_TOP      3328
#define XB_TOPGEN   3392
#define XCD_BAR_WORDS 3456
#define XB_SPIN_CAP (1u << 18)

__device__ __forceinline__ unsigned xb_ld(unsigned* p)              { return __hip_atomic_load(p, __ATOMIC_RELAXED, __HIP_MEMORY_SCOPE_AGENT); }
__device__ __forceinline__ unsigned xb_add(unsigned* p, unsigned v) { return __hip_atomic_fetch_add(p, v, __ATOMIC_RELAXED, __HIP_MEMORY_SCOPE_AGENT); }
__device__ __forceinline__ unsigned xb_xcc_id() { return (unsigned)__builtin_amdgcn_s_getreg((3 << 11) | 20) & 0xFu; }
#define XB_SPIN(cond, bar) do { unsigned _sp = 0; while (cond) { __builtin_amdgcn_s_sleep(1); \
    if ((++_sp & 255u) == 0u) { if (xb_ld(&(bar)[XB_TMO])) break; if (_sp > XB_SPIN_CAP) { atomicAdd(&(bar)[XB_TMO], 1u); break; } } } } while (0)

struct XcdBarrier {
    unsigned* bar; unsigned x;
    volatile LAS unsigned* st;
};

__device__ __forceinline__ XcdBarrier xcd_barrier_post(unsigned* bar, volatile LAS unsigned* st) {
    XcdBarrier b; b.bar = bar; b.x = xb_xcc_id(); b.st = st;
    if (threadIdx.x == 0) (void)xb_add(&bar[XB_XCNT(b.x)], 1u);
    return b;
}
__device__ __forceinline__ void xcd_barrier_complete(unsigned* bar, unsigned x, unsigned& nloc, unsigned& nx) {
    const unsigned G = gridDim.x * gridDim.y * gridDim.z;
    unsigned sum, cnt, mine, sp = 0u;
    for (;;) {
        sum = 0u; cnt = 0u; mine = 0u;
#pragma unroll
        for (unsigned j = 0; j < 16; ++j) { const unsigned c = xb_ld(&bar[XB_XCNT(j)]); sum += c; cnt += (c > 0u) ? 1u : 0u; mine = (j == x) ? c : mine; }
        if (sum == G) break;
        __builtin_amdgcn_s_sleep(1);
        if ((++sp & 255u) == 0u) { if (xb_ld(&bar[XB_TMO])) break; if (sp > XB_SPIN_CAP) { atomicAdd(&bar[XB_TMO], 1u); break; } }
    }
    nloc = mine > 0u ? mine : 1u; nx = cnt > 0u ? cnt : 1u;
}

__device__ __forceinline__ void xcd_barrier(const XcdBarrier& b) {
    asm volatile("s_waitcnt vmcnt(0)" ::: "memory");
    __syncthreads();
    if (threadIdx.x == 0) {
        unsigned* bar = b.bar;
        __builtin_amdgcn_s_waitcnt(0);
        unsigned nloc = b.st[0], nx = b.st[1];
        if (nloc == 0u) { xcd_barrier_complete(bar, b.x, nloc, nx); b.st[0] = nloc; b.st[1] = nx; }
        const unsigned old = xb_add(&bar[XB_XSUB(b.x)], 1u);
        const unsigned gen = old / nloc;
        if (old + 1u == (gen + 1u) * nloc) {
            __builtin_amdgcn_fence(__ATOMIC_RELEASE, "agent");
            asm volatile("s_waitcnt vmcnt(0)" ::: "memory");
            const unsigned og = xb_add(&bar[XB_TOP], 1u);
            const unsigned tg = og / nx;
            if (og + 1u == (tg + 1u) * nx) xb_add(&bar[XB_TOPGEN], 1u);
            else XB_SPIN(xb_ld(&bar[XB_TOPGEN]) == tg, bar);
            __builtin_amdgcn_fence(__ATOMIC_ACQUIRE, "agent");
            xb_add(&bar[XB_XGEN(b.x)], 1u);
            asm volatile("s_waitcnt vmcnt(0)" ::: "memory");
        } else {
            XB_SPIN(xb_ld(&bar[XB_XGEN(b.x)]) == gen, bar);
            __builtin_amdgcn_fence(__ATOMIC_ACQUIRE, "agent");
            asm volatile("s_waitcnt vmcnt(0)" ::: "memory");
        }
    }
    __syncthreads();
}

#define LB_SUB(j) (XCD_BAR_WORDS + 64 + 64 * (j))
#define LB_GEN(j) (XCD_BAR_WORDS + 64 + 512 + 64 * (j))
#define G_BAR_WORDS (XCD_BAR_WORDS + 64 + 1024)
__device__ unsigned g_bar[G_BAR_WORDS];
__device__ __forceinline__ void xcd_local_barrier(const XcdBarrier& b) {
    asm volatile("s_waitcnt vmcnt(0)" ::: "memory");
    __syncthreads();
    if (threadIdx.x == 0) {
        __builtin_amdgcn_s_waitcnt(0);
        unsigned* bar = b.bar;
        const unsigned old = xb_add(&bar[LB_SUB(b.x)], 1u), gen = old / 32u;
        if (old + 1u == (gen + 1u) * 32u) xb_add(&bar[LB_GEN(b.x)], 1u);
        else XB_SPIN(xb_ld(&bar[LB_GEN(b.x)]) == gen, bar);
        __builtin_amdgcn_fence(__ATOMIC_ACQUIRE, "agent");
        asm volatile("s_waitcnt vmcnt(0)" ::: "memory");
    }
    __syncthreads();
}
struct Args { const float* in[18]; float* out; unsigned char* ws; int ph_lo, ph_hi; };
enum { I_X = 0, I_GMIX, I_WIN, I_BGATE, I_CONVW, I_QN, I_KN, I_LQ1, I_LK1, I_LQ2, I_LK2, I_SUBN, I_WCO, I_WAO, I_WO, I_GFFN, I_WGU, I_WDN };

__global__ void __launch_bounds__(NWAVES * 64, 2) hybrid_fwd(Args args) {
    extern __shared__ __attribute__((aligned(16))) unsigned char lds[];
    LAS unsigned char* L = (LAS unsigned char*)lds;
    const int tid = threadIdx.x, lane = tid & 63, wave = __builtin_amdgcn_readfirstlane(tid >> 6);
    const int G = gridDim.x, bx = blockIdx.x, vcu = (G % 8 == 0) ? (bx % 8) * (G / 8) + bx / 8 : bx;
    unsigned char* ws = args.ws;
    const float* x = args.in[I_X]; float* out = args.out;
    bf16 *Win = (bf16*)(ws + WS_WIN), *Wgu = (bf16*)(ws + WS_WGU), *Wdn = (bf16*)(ws + WS_WDN), *Wo = (bf16*)(ws + WS_WO), *Wc = (bf16*)(ws + WS_WC), *Wa = (bf16*)(ws + WS_WA);
    bf16 *XB = (bf16*)(ws + WS_XB), *X1B = (bf16*)(ws + WS_X1B), *BC = (bf16*)(ws + WS_BC), *U = (bf16*)(ws + WS_U), *M1 = (bf16*)out  ;
    bf16 *Qb = (bf16*)(ws + WS_Q), *Kb = (bf16*)(ws + WS_K), *Vb = (bf16*)(ws + WS_V), *Gb = (bf16*)(ws + WS_G), *CM = (bf16*)(ws + WS_CM), *Ob = (bf16*)(ws + WS_O), *ACT = (bf16*)(ws + WS_ACT);
    float *O0 = out  , *RS1 = (float*)(ws + WS_RS1), *SS = (float*)(ws + WS_SS), *COS = (float*)(ws + WS_COS), *SIN = (float*)(ws + WS_SIN);
    const int lo = args.ph_lo, hi = args.ph_hi;
    volatile LAS unsigned* MISC = (volatile LAS unsigned*)(L + MISC_OFF);
    if (tid < 32) MISC[tid] = 0u;
    __syncthreads();
    XcdBarrier bar; bar.bar = g_bar; bar.x = xb_xcc_id(); bar.st = MISC + 8;
    if (tid == 0) MISC[2] = xb_add(&g_bar[XB_XCNT(bar.x)], 1u);
    if (hi > 1000) cg::this_grid().sync();
#define IN(k) (lo <= (k) && (k) < hi)
#define SEAM(k) do { if (IN(k) && IN((k) + 1)) xcd_barrier(bar); } while (0)

    if (IN(0)) {
        LAS float* scr = (LAS float*)(L + wave * 16384);
        const int gw = vcu * NWAVES + wave, NGW = G * NWAVES;
        constexpr int I_1 = (D / 64) * (INC / 32), I_2 = (D / 64) * (FF2 / 32), I_3 = (FF / 64) * (D / 32), I_4 = (D / 64) * (D / 32), I_5 = (DC / 64) * (D / 32), I_6 = I_5;
        constexpr int NITEMS = I_1 + I_2 + I_3 + I_4 + I_5 + I_6;
        for (int it = gw; it < NITEMS; it += NGW) {
            int r = it;
            if (r < I_1) { p0_transpose_item<1>(args.in[I_WIN], D, INC, Win, args.in[I_GMIX], 0x7fffffff, 1.0f, scr, r, lane); continue; } r -= I_1;
            if (r < I_2) { p0_transpose_item<2>(args.in[I_WGU], D, FF2, Wgu, args.in[I_GFFN], 0x7fffffff, 1.0f, scr, r, lane); continue; } r -= I_2;
            if (r < I_3) { p0_transpose_item<0>(args.in[I_WDN], FF, D, Wdn, nullptr, 0, 1.0f, scr, r, lane); continue; } r -= I_3;
            if (r < I_4) { p0_transpose_item<0>(args.in[I_WO], D, D, Wo, nullptr, 0, 1.0f, scr, r, lane); continue; } r -= I_4;
            if (r < I_5) { p0_transpose_item<0>(args.in[I_WCO], DC, D, Wc, nullptr, 0, 1.0f, scr, r, lane); continue; } r -= I_5;
            p0_transpose_item<0>(args.in[I_WAO], NV, D, Wa, args.in[I_SUBN], 127, 0.8f, scr, r, lane);
        }
        for (int m0 = gw * 4; m0 < M; m0 += NGW * 4) {
            f32x4 v[4][4]; float s2[4];
#pragma unroll
            for (int r = 0; r < 4; ++r) { const GAS f32x4* xr = (const GAS f32x4*)(x + (size_t)(m0 + r) * D) + lane;
#pragma unroll
                for (int j = 0; j < 4; ++j) v[r][j] = __builtin_nontemporal_load(xr + 64 * j); }
#pragma unroll
            for (int r = 0; r < 4; ++r) { float a = 0.f;
#pragma unroll
                for (int j = 0; j < 4; ++j) a += (v[r][j].x * v[r][j].x + v[r][j].y * v[r][j].y) + (v[r][j].z * v[r][j].z + v[r][j].w * v[r][j].w);
                s2[r] = wave_sum(a) * (1.0f / D) + 1e-6f;
                const float rstd = 1.0f / sqrtf(s2[r]);
                GAS unsigned long long* o8 = (GAS unsigned long long*)(XB + (size_t)(m0 + r) * D) + lane;
#pragma unroll
                for (int j = 0; j < 4; ++j) o8[64 * j] = (unsigned long long)pk2(v[r][j].x * rstd, v[r][j].y * rstd) | ((unsigned long long)pk2(v[r][j].z * rstd, v[r][j].w * rstd) << 32); }
            if (lane < 4) SS[m0 + lane] = 0.f;
            if (lane < 4) RS1[m0 + lane] = sqrtf(lane == 0 ? s2[0] : lane == 1 ? s2[1] : lane == 2 ? s2[2] : s2[3]);
        }
        for (int e = vcu * 512 + tid; e < SEQ * 32; e += G * 512) {
            const int pos = e >> 5, i = e & 31;
            const float inv = __builtin_amdgcn_exp2f(-(float)i * (13.287712379549449f / 32.0f)); const float ang = (float)pos * inv;
            const double rv = (double)ang * 0.15915494309189535; const float fr = (float)(rv - __builtin_rint(rv));
            ((unsigned*)COS)[e] = pk2(__builtin_amdgcn_cosf(fr), __builtin_amdgcn_sinf(fr));
        }
    }
    SEAM(0);
    if (tid == 0) { unsigned okc = (G == 256 && IN(0) && IN(6)) ? 1u : 0u;
        for (unsigned j = 0; j < 16; ++j) { const unsigned c = xb_ld(&g_bar[XB_XCNT(j)]); if (c != (j < 8 ? 32u : 0u)) okc = 0u; }
        MISC[3] = okc; }
    __syncthreads();
    const bool xok = MISC[3] != 0u;
    const int vbx = xok ? (int)(bar.x + 8u * MISC[2]) : bx, vcu2 = xok ? (int)(bar.x * 32u + MISC[2]) : vcu;
#define SEAML(k) do { if (IN(k) && IN((k) + 1)) { if (xok) xcd_local_barrier(bar); else xcd_barrier(bar); } } while (0)

    if (IN(1)) {
        pg8::Gemm g{XB, XB, Win, Win, M, INC, D}; pg8::StaticOrder S; S.init(M, INC, G, vbx);
        pg8::EpiInProj E{BC, U, Qb, Kb, Vb, Gb, args.in[I_BGATE], args.in[I_QN], args.in[I_KN], COS, SIN};
        pg8::gemm_phase<pg8::EpiInProj, pg8::StaticOrder, true, true>(L, g, S, E);
    }
    SEAML(1);

    if (IN(2)) {
#define P2_CONV() do { \
        { \
            const float* cw = args.in[I_CONVW]; \
            for (int it = vcu2 * 512 + tid; it < (M / 16) * 64; it += G * 512) { \
                const int cg8 = it & 63, r0 = (it >> 6) * 16, c0 = cg8 * 8, t0 = r0 & (SEQ - 1); \
                f32x4 w0a = *(const f32x4*)(cw + c0), w0b = *(const f32x4*)(cw + c0 + 4), w1a = *(const f32x4*)(cw + 512 + c0), w1b = *(const f32x4*)(cw + 512 + c0 + 4), w2a = *(const f32x4*)(cw + 1024 + c0), w2b = *(const f32x4*)(cw + 1024 + c0 + 4); \
                f32x4 um2a = {0.f, 0.f, 0.f, 0.f}, um2b = um2a, um1a = um2a, um1b = um2a; \
                if (t0 >= 2) { pg8::load8nt(U + (size_t)(r0 - 2) * 512 + c0, um2a, um2b); pg8::load8nt(U + (size_t)(r0 - 1) * 512 + c0, um1a, um1b); } \
                _Pragma("unroll 4") \
                for (int i = 0; i < 16; ++i) { const size_t o = (size_t)(r0 + i) * 512 + c0; f32x4 ua, ub, ba, bb; pg8::load8nt(U + o, ua, ub); pg8::load8nt(BC + o, ba, bb); \
                    const f32x4 ya = ba * (w0a * um2a + w1a * um1a + w2a * ua), yb = bb * (w0b * um2b + w1b * um1b + w2b * ub); \
                    pg8::store8(CM + o, ya, yb); um2a = um1a; um2b = um1b; um1a = ua; um1b = ub; } \
            } \
        } \
        } while (0)
        const bool conv_first = (vcu2 & 1) == 0;
        if (conv_first) P2_CONV();
        const float lq1 = args.in[I_LQ1][lane] * args.in[I_LK1][lane], lq2 = args.in[I_LQ2][lane] * args.in[I_LK2][lane];
        const float lam = expf(wave_sum(lq1)) - expf(wave_sum(lq2)) + 0.2f;
        __syncthreads();
        if (G == 256) {
            const int xg = vcu2 >> 5, j = vcu2 & 31;
            for (int r = 0; r < 4; ++r) { const int bh = xg * 4 + r, qb = (r & 1) ? 31 - j : j; att::attn_unit(bh >> 2, bh & 3, qb, Qb, Kb, Vb, Ob, (LAS char*)L, lam); }
        } else {
            for (int u = vcu2; u < 1024; u += G) { const int bh = u >> 5, qb = u & 31; att::attn_unit(bh >> 2, bh & 3, qb, Qb, Kb, Vb, Ob, (LAS char*)L, lam); }
        }
        if (!conv_first) P2_CONV();
#undef P2_CONV
    }
    SEAML(2);

    if (IN(3)) {
        pg8::Gemm g{CM, Ob, Wc, Wa, M, D, DC}; pg8::DualOrder S; S.init(M, D, G, vbx);
        pg8::EpiDual E{Gb, M1};
        pg8::gemm_phase<pg8::EpiDual, pg8::DualOrder, true, true>(L, g, S, E);
    }
    SEAML(3);

    if (IN(4)) {
        pg8::Gemm g{M1, M1, Wo, Wo, M, D, D}; pg8::StaticOrder S; S.init(M, D, G, vbx);
        pg8::EpiX1 E{X1B, RS1, SS};
        pg8::gemm_phase<pg8::EpiX1, pg8::StaticOrder, true, true>(L, g, S, E);
    }
    SEAM(4);

    if (IN(5)) {
        pg8::Gemm g{X1B, X1B, Wgu, Wgu, M, FF2, D}; pg8::StaticOrder S; S.init(M, FF2, G, vbx);
        pg8::EpiGateUp E{SS, ACT};
        pg8::gemm_phase<pg8::EpiGateUp, pg8::StaticOrder, true, true>(L, g, S, E);
    }
    SEAML(5);

    if (IN(6)) {
        pg8::Gemm g{ACT, ACT, Wdn, Wdn, M, D, FF}; pg8::StaticOrder S; S.init(M, D, G, vbx);
        pg8::EpiDown E{X1B, out};
        pg8::gemm_phase<pg8::EpiDown, pg8::StaticOrder, true, true>(L, g, S, E);
    }
    if (lo == 0 && hi == N_PHASES) {
        __syncthreads();
        if (tid == 0) MISC[0] = (xb_add(&g_bar[XCD_BAR_WORDS], 1u) == (unsigned)G - 1u) ? 1u : 0u;
        __syncthreads();
        if (MISC[0]) for (int i = tid; i < G_BAR_WORDS; i += NWAVES * 64) g_bar[i] = 0u;
    }
#undef IN
#undef SEAM
#undef SEAML
}

extern "C" void kernel_launch(void* const* d_in, const int* in_sizes, int n_in, void* d_out, int out_size, void* d_ws, size_t ws_size, hipStream_t stream) {
    static int grid = 0;
    if (grid == 0) {
        if (n_in != 18 || in_sizes[0] != M * D || out_size != M * D || ws_size < WS_END) { fprintf(stderr, "kernel_launch: unexpected shapes (n_in %d, in0 %d, out %d, ws %zu); nothing launched\n", n_in, n_in > 0 ? in_sizes[0] : -1, out_size, ws_size); grid = -1; return; }
        int dev = 0, cus = 0, per_cu = 0;
        if (hipGetDevice(&dev) != hipSuccess || hipDeviceGetAttribute(&cus, hipDeviceAttributeMultiprocessorCount, dev) != hipSuccess) { grid = -1; return; }
        if (hipFuncSetAttribute((const void*)hybrid_fwd, hipFuncAttributeMaxDynamicSharedMemorySize, LDS_BYTES) != hipSuccess) { fprintf(stderr, "kernel_launch: hipFuncSetAttribute failed\n"); grid = -1; return; }
        if (hipOccupancyMaxActiveBlocksPerMultiprocessor(&per_cu, (const void*)hybrid_fwd, NWAVES * 64, LDS_BYTES) != hipSuccess || per_cu < 1) { fprintf(stderr, "kernel_launch: occupancy query gives %d\n", per_cu); per_cu = 1; }
        (void)hipGetLastError();
        grid = cus * 1;
    }
    if (grid < 0) return;
    Args a{};
    for (int i = 0; i < 18; ++i) a.in[i] = (const float*)d_in[i];
    a.out = (float*)d_out; a.ws = (unsigned char*)d_ws;
#if MK_N_LAUNCHES == 1
    a.ph_lo = 0; a.ph_hi = N_PHASES;
    void* kargs[] = {&a};
    hipError_t e = hipLaunchCooperativeKernel((const void*)hybrid_fwd, dim3(grid), dim3(NWAVES * 64), kargs, LDS_BYTES, stream);
    if (e != hipSuccess) fprintf(stderr, "kernel_launch: cooperative launch failed: %s (grid %d)\n", hipGetErrorString(e), grid);
#else
    for (int p = 0; p < N_PHASES; ++p) { a.ph_lo = p; a.ph_hi = p + 1; hipLaunchKernelGGL(hybrid_fwd, dim3(grid), dim3(NWAVES * 64), LDS_BYTES, stream, a); }
#endif
}
```

```cpp
#include <hip/hip_runtime.h>
#include <hip/hip_cooperative_groups.h>
#include <cstdio>
#include <cstdint>
namespace cg = cooperative_groups;

namespace pg8 {
#define PG8_LAS __attribute__((address_space(3)))
typedef unsigned short bf16_t;
typedef short bf16x8 __attribute__((ext_vector_type(8)));
typedef float f32x4 __attribute__((ext_vector_type(4)));
typedef unsigned u32x4 __attribute__((ext_vector_type(4)));
typedef unsigned u32x2 __attribute__((ext_vector_type(2)));
constexpr int BM = 256, BK = 64, HALF = 128, HTB = HALF * BK * 2  , STAGE_BYTES = 8 * HTB, NXCD = 8, WGM = 4;

__host__ __device__ __forceinline__ int lds_byte(int r, int c) { const int st = (r >> 4) * 2 + (c >> 5), rr = r & 15, cc = c & 31, ob = rr * 64 + cc * 2; return st * 1024 + (ob ^ (((ob >> 9) & 1) << 5)); }
__host__ __device__ __forceinline__ void stage_rc(int b, int& R, int& C) { const int st = b / 1024, sb = b % 1024, swz = sb ^ (((sb >> 9) & 1) << 5); R = (st >> 1) * 16 + swz / 64; C = (st & 1) * 32 + (swz % 64) / 2; }
__host__ __device__ __forceinline__ int perm32(int rho) { const int n = rho >> 4, i = rho & 15; return 8 * (i >> 2) + 4 * n + (i & 3); }

struct Unit { int pm, pn, seg; };
struct Gemm { const bf16_t* A0; const bf16_t* A1; const bf16_t* B0; const bf16_t* B1; int M, N, K; };

struct StaticOrder {
    int nM, nN, nwg, G, c, rep;
    __host__ __device__ void init(int M, int N, int G_, int c_, int rep_ = 1) { nM = M / BM; nN = N / BM; nwg = nM * nN; G = G_; c = c_; rep = rep_; }
    __host__ __device__ bool next(int i, Unit& u) const {
        long L = (long)i * G + c; if (L >= (long)nwg * rep) return false; L %= nwg;
        int wgid = (int)L; { const int q = nwg / NXCD, r = nwg % NXCD, xcd = wgid % NXCD, off = wgid / NXCD; wgid = (xcd < r ? xcd * (q + 1) : r * (q + 1) + (xcd - r) * q) + off; }
        const int nig = WGM * nN, gid = wgid / nig, fm = gid * WGM, gsz = (nM - fm) < WGM ? (nM - fm) : WGM;
        u.pm = fm + ((wgid % nig) % gsz); u.pn = (wgid % nig) / gsz; u.seg = 0; return true;
    }
    __device__ __forceinline__ void a_ready(const Unit&) const {}
    __device__ __forceinline__ void done(const Unit&) const {}
};
struct DualOrder {
    StaticOrder so;
    __host__ __device__ void init(int M, int N, int G_, int c_, int rep_ = 1) { so.init(M, N, G_, c_, rep_); }
    __host__ __device__ bool next(int i, Unit& u) const { if (!so.next(i >> 1, u)) return false; u.seg = i & 1; return true; }
    __device__ __forceinline__ void a_ready(const Unit&) const {}
    __device__ __forceinline__ void done(const Unit&) const {}
};

typedef float f32x2v_ __attribute__((ext_vector_type(2))); typedef __bf16 bf16x2v_ __attribute__((ext_vector_type(2)));
__device__ __forceinline__ unsigned cvt_pk_bf16(float lo, float hi) { f32x2v_ v = {lo, hi}; bf16x2v_ b = __builtin_convertvector(v, bf16x2v_); return __builtin_bit_cast(unsigned, b); }
__device__ __forceinline__ void store8(bf16_t* p, f32x4 a, f32x4 b) { u32x4 w; w.x = cvt_pk_bf16(a[0], a[1]); w.y = cvt_pk_bf16(a[2], a[3]); w.z = cvt_pk_bf16(b[0], b[1]); w.w = cvt_pk_bf16(b[2], b[3]); *(u32x4*)p = w; }
__device__ __forceinline__ void store8nt(bf16_t* p, f32x4 a, f32x4 b) { u32x4 w; w.x = cvt_pk_bf16(a[0], a[1]); w.y = cvt_pk_bf16(a[2], a[3]); w.z = cvt_pk_bf16(b[0], b[1]); w.w = cvt_pk_bf16(b[2], b[3]); __builtin_nontemporal_store(w, (u32x4*)p); }
__device__ __forceinline__ void load8(const bf16_t* p, f32x4& a, f32x4& b) { const u32x4 w = *(const u32x4*)p;
    a[0] = __uint_as_float(w.x << 16); a[1] = __uint_as_float(w.x & 0xffff0000u); a[2] = __uint_as_float(w.y << 16); a[3] = __uint_as_float(w.y & 0xffff0000u);
    b[0] = __uint_as_float(w.z << 16); b[1] = __uint_as_float(w.z & 0xffff0000u); b[2] = __uint_as_float(w.w << 16); b[3] = __uint_as_float(w.w & 0xffff0000u); }
__device__ __forceinline__ void load8nt(const bf16_t* p, f32x4& a, f32x4& b) { const u32x4 w = __builtin_nontemporal_load((const u32x4*)p);
    a[0] = __uint_as_float(w.x << 16); a[1] = __uint_as_float(w.x & 0xffff0000u); a[2] = __uint_as_float(w.y << 16); a[3] = __uint_as_float(w.y & 0xffff0000u);
    b[0] = __uint_as_float(w.z << 16); b[1] = __uint_as_float(w.z & 0xffff0000u); b[2] = __uint_as_float(w.w << 16); b[3] = __uint_as_float(w.w & 0xffff0000u); }
__device__ __forceinline__ float sigmoidf_(float x) { return __builtin_amdgcn_rcpf(1.0f + __builtin_amdgcn_exp2f(-1.4426950408889634f * x)); }
__device__ __forceinline__ f32x4 sigmoid4(f32x4 x) { f32x4 r; r[0] = sigmoidf_(x[0]); r[1] = sigmoidf_(x[1]); r[2] = sigmoidf_(x[2]); r[3] = sigmoidf_(x[3]); return r; }

constexpr float QK_C2 = 0.125f * 1.4426950408889634f;
constexpr float NORM_EPS = 1e-6f;

struct EpiInProj {
    static constexpr bool PERM = true, AFTER_DRAIN = false, KEEP = false;
    bf16_t *BC, *U, *Q, *Kb, *V, *G; const float* bgate; const float* qn; const float* kn; const float* costab; const float* sintab;
    __device__ __forceinline__ void operator()(const f32x4 (&acc)[2][2][4][2], const Unit& u, int wr, int wc, int fr, int fq) const {
        const int row0 = u.pm * BM + wr * 64 + fr, pn = u.pn, c8 = wc * 32 + 8 * fq;
        if (pn < 2 || (pn >= 10 && pn < 12)) {
            bf16_t* base = (pn < 2) ? (BC + pn * 256) : (V + (pn - 10) * 256);
#pragma unroll
            for (int ai = 0; ai < 2; ++ai)
#pragma unroll
                for (int m = 0; m < 4; ++m) { const int row = row0 + ai * HALF + m * 16; bf16_t* rp = base + (size_t)row * 512 + c8;
#pragma unroll
                    for (int bj = 0; bj < 2; ++bj) store8(rp + bj * HALF, acc[ai][bj][m][0], acc[ai][bj][m][1]); }
        } else if (pn < 6) {
            bf16_t* base = U + (pn - 2) * 128;
#pragma unroll
            for (int ai = 0; ai < 2; ++ai)
#pragma unroll
                for (int m = 0; m < 4; ++m) { const int row = row0 + ai * HALF + m * 16;
                    store8(base + (size_t)row * 512 + c8, acc[ai][0][m][0] * acc[ai][1][m][0], acc[ai][0][m][1] * acc[ai][1][m][1]); }
        } else if (pn < 10) {
            const bool isq = pn < 8; bf16_t* base = (isq ? (Q + (pn - 6) * 256) : (Kb + (pn - 8) * 256)) + wc * 64 + 8 * fq; const float* g = isq ? qn : kn; const float sc = isq ? QK_C2 : 1.0f;
            f32x4 gw[2][2];
#pragma unroll
            for (int bj = 0; bj < 2; ++bj)
#pragma unroll
                for (int n = 0; n < 2; ++n) gw[bj][n] = *(const f32x4*)(g + 32 * bj + 8 * fq + 4 * n);
#pragma unroll
            for (int ai = 0; ai < 2; ++ai)
#pragma unroll
                for (int m = 0; m < 4; ++m) { const int row = row0 + ai * HALF + m * 16;
                    float ss = 0.f;
#pragma unroll
                    for (int bj = 0; bj < 2; ++bj)
#pragma unroll
                        for (int n = 0; n < 2; ++n) { const f32x4 q = acc[ai][bj][m][n] * acc[ai][bj][m][n]; ss += (q[0] + q[1]) + (q[2] + q[3]); }
                    ss += __shfl_xor(ss, 16); ss += __shfl_xor(ss, 32);
                    const float rn = __builtin_amdgcn_rsqf(ss * (1.0f / 64.0f) + NORM_EPS) * sc;
                    const int pos = row & 4095; f32x4 o0[2], o1[2];
#pragma unroll
                    for (int n = 0; n < 2; ++n) { const u32x4 tw = *(const u32x4*)((const unsigned*)costab + pos * 32 + 8 * fq + 4 * n); f32x4 cv, sv;
#pragma unroll
                        for (int e = 0; e < 4; ++e) { cv[e] = __uint_as_float(tw[e] << 16); sv[e] = __uint_as_float(tw[e] & 0xffff0000u); }
                        const f32x4 a = acc[ai][0][m][n] * gw[0][n] * rn, b = acc[ai][1][m][n] * gw[1][n] * rn; o0[n] = a * cv - b * sv; o1[n] = b * cv + a * sv; }
                    bf16_t* rp = base + (size_t)row * 512; store8(rp, o0[0], o0[1]); store8(rp + 32, o1[0], o1[1]); }
        } else {
            const int gcol = (pn - 12) * 128 + c8; f32x4 bv[2][2];
#pragma unroll
            for (int bj = 0; bj < 2; ++bj)
#pragma unroll
                for (int n = 0; n < 2; ++n) bv[bj][n] = *(const f32x4*)(bgate + bj * 1024 + gcol + 4 * n);
#pragma unroll
            for (int ai = 0; ai < 2; ++ai)
#pragma unroll
                for (int m = 0; m < 4; ++m) { const int row = row0 + ai * HALF + m * 16; bf16_t* rp = G + (size_t)row * 2048 + gcol; f32x4 r[2], ga[2];
#pragma unroll
                    for (int n = 0; n < 2; ++n)
#pragma unroll
                        for (int e = 0; e < 4; ++e) { const float ec = 1.0f + __builtin_amdgcn_exp2f(-1.4426950408889634f * (acc[ai][0][m][n][e] + bv[0][n][e])), ea = 1.0f + __builtin_amdgcn_exp2f(-1.4426950408889634f * (acc[ai][1][m][n][e] + bv[1][n][e]));
                            r[n][e] = ea * __builtin_amdgcn_rcpf(ec); ga[n][e] = __builtin_amdgcn_rcpf(ea); }
                    store8nt(rp, r[0], r[1]); store8nt(rp + 1024, ga[0], ga[1]); }
        }
    }
};
struct EpiDual {
    static constexpr bool PERM = true, AFTER_DRAIN = false, KEEP = true;
    const bf16_t* G; bf16_t* M1;
    __device__ __forceinline__ void operator()(f32x4 (&acc)[2][2][4][2], const Unit& u, int wr, int wc, int fr, int fq) const {
        const int row0 = u.pm * BM + wr * 64 + fr, col0 = u.pn * BM + wc * 32 + 8 * fq;
        if (u.seg == 0) {
#pragma unroll
            for (int ai = 0; ai < 2; ++ai)
#pragma unroll
                for (int m = 0; m < 4; ++m) { const int row = row0 + ai * HALF + m * 16; const bf16_t* gp = G + (size_t)row * 2048 + col0;
#pragma unroll
                    for (int bj = 0; bj < 2; ++bj) { f32x4 c0, c1; load8nt(gp + bj * HALF, c0, c1); acc[ai][bj][m][0] *= c0; acc[ai][bj][m][1] *= c1; } }
        } else {
#pragma unroll
            for (int ai = 0; ai < 2; ++ai)
#pragma unroll
                for (int m = 0; m < 4; ++m) { const int row = row0 + ai * HALF + m * 16; const bf16_t* gp = G + (size_t)row * 2048 + 1024 + col0; bf16_t* mp = M1 + (size_t)row * 1024 + col0;
#pragma unroll
                    for (int bj = 0; bj < 2; ++bj) { f32x4 a0, a1; load8nt(gp + bj * HALF, a0, a1); store8(mp + bj * HALF, a0 * acc[ai][bj][m][0], a1 * acc[ai][bj][m][1]); } }
        }
    }
};
struct EpiX1 {
    static constexpr bool PERM = true, AFTER_DRAIN = false, KEEP = false;
    bf16_t* X1B; const float* irs; float* SS;
    __device__ __forceinline__ void operator()(const f32x4 (&acc)[2][2][4][2], const Unit& u, int wr, int wc, int fr, int fq) const {
        const int row0 = u.pm * BM + wr * 64 + fr, col0 = u.pn * BM + wc * 32 + 8 * fq, lane = 16 * fq + fr;
        float irl[2];
#pragma unroll
        for (int ai = 0; ai < 2; ++ai) irl[ai] = irs[u.pm * BM + ai * HALF + wr * 64 + lane];
#pragma unroll
        for (int ai = 0; ai < 2; ++ai)
#pragma unroll
            for (int m = 0; m < 4; ++m) { const int row = row0 + ai * HALF + m * 16; bf16_t* xp = X1B + (size_t)row * 1024 + col0; const float ir = __shfl(irl[ai], 16 * m + fr); float ss = 0.f;
#pragma unroll
                for (int bj = 0; bj < 2; ++bj) { f32x4 x0, x1; load8nt(xp + bj * HALF, x0, x1); const f32x4 v0 = x0 * ir + acc[ai][bj][m][0], v1 = x1 * ir + acc[ai][bj][m][1];
                    store8(xp + bj * HALF, v0, v1); const f32x4 q = v0 * v0 + v1 * v1; ss += (q[0] + q[1]) + (q[2] + q[3]); }
                ss += __shfl_xor(ss, 16); ss += __shfl_xor(ss, 32);
                if (fq == 0) unsafeAtomicAdd(SS + row, ss); }
    }
};
struct EpiGateUp {
    static constexpr bool PERM = true, AFTER_DRAIN = false, KEEP = false;
    const float* SS; bf16_t* ACT;
    __device__ __forceinline__ void operator()(const f32x4 (&acc)[2][2][4][2], const Unit& u, int wr, int wc, int fr, int fq) const {
        const int row0 = u.pm * BM + wr * 64 + fr, col0 = u.pn * 128 + wc * 32 + 8 * fq, lane = 16 * fq + fr;
        float rsl[2];
#pragma unroll
        for (int ai = 0; ai < 2; ++ai) rsl[ai] = __builtin_amdgcn_rsqf(SS[u.pm * BM + ai * HALF + wr * 64 + lane] * (1.0f / 1024.0f) + NORM_EPS);
#pragma unroll
        for (int ai = 0; ai < 2; ++ai)
#pragma unroll
            for (int m = 0; m < 4; ++m) { const int row = row0 + ai * HALF + m * 16; const float rs = __shfl(rsl[ai], 16 * m + fr);
                f32x4 a[2];
#pragma unroll
                for (int n = 0; n < 2; ++n) { const f32x4 g = acc[ai][0][m][n] * rs, up = acc[ai][1][m][n] * rs; a[n] = g * sigmoid4(g) * up; }
                store8(ACT + (size_t)row * 2816 + col0, a[0], a[1]); }
    }
};
struct EpiDown {
    static constexpr bool PERM = true, AFTER_DRAIN = false, KEEP = false;
    const bf16_t* X1B; float* out;
    __device__ __forceinline__ void operator()(const f32x4 (&acc)[2][2][4][2], const Unit& u, int wr, int wc, int fr, int fq) const {
        const int row0 = u.pm * BM + wr * 64 + fr, col0 = u.pn * BM + wc * 32 + 8 * fq;
#pragma unroll
        for (int ai = 0; ai < 2; ++ai)
#pragma unroll
            for (int m = 0; m < 4; ++m) { const size_t off = (size_t)(row0 + ai * HALF + m * 16) * 1024 + col0;
#pragma unroll
                for (int bj = 0; bj < 2; ++bj) { f32x4 x0, x1; load8nt(X1B + off + bj * HALF, x0, x1); float* op = out + off + bj * HALF;
                    __builtin_nontemporal_store(x0 + acc[ai][bj][m][0], (f32x4*)op); __builtin_nontemporal_store(x1 + acc[ai][bj][m][1], (f32x4*)(op + 4)); } }
    }
};

template <class Epi, class Sched, bool ALIGN_EPI = false, bool SP2 = false>
__device__ __forceinline__ void gemm_phase(PG8_LAS unsigned char* lds, const Gemm g, const Sched& S, const Epi& E) {
    const int tid = threadIdx.x, wid = __builtin_amdgcn_readfirstlane(tid >> 6), lane = tid & 63, wr = wid >> 2, wc = wid & 3, fr = lane & 15, fq = lane >> 4;
    const int K = g.K, nt = K / BK;
    unsigned voffA[2], voffB[2];
#pragma unroll
    for (int i = 0; i < 2; ++i) { int R, C; stage_rc(tid * 16 + i * 8192, R, C); const int Rb = Epi::PERM ? ((R & ~31) + perm32(R & 31)) : R;
        voffA[i] = (unsigned)(R * K + C) * 2u; voffB[i] = (unsigned)(Rb * K + C) * 2u; }
    const size_t kstep = (size_t)(BK * 2);
    const size_t hstep = (size_t)HALF * K * 2;
    const size_t tstep = 2 * hstep;
    const unsigned ldsw = (unsigned)wid * 1024u;
    const int aoff = lds_byte(wr * 64 + fr, fq * 8), boff = lds_byte(wc * 32 + fr, fq * 8);
#define PG8_SA(b, h) (((b) * 2 + (h)) * HTB)
#define PG8_SB(b, h) ((4 + (b) * 2 + (h)) * HTB)
#define PG8_STAGE(bufoff, gbase, voff) do { _Pragma("unroll") for (int _i = 0; _i < 2; ++_i) \
        __builtin_amdgcn_global_load_lds((const unsigned*)((const char*)(gbase) + (voff)[_i]), (PG8_LAS unsigned*)(lds + (bufoff) + ldsw + _i * 8192), 16, 0, 0); } while (0)
#define PG8_LDA(dst, b, h) do { _Pragma("unroll") for (int m = 0; m < 4; ++m) _Pragma("unroll") for (int k = 0; k < 2; ++k) dst[m][k] = *(const PG8_LAS bf16x8*)(lds + PG8_SA(b, h) + aoff + m * 2048 + k * 1024); } while (0)
#define PG8_LDB(dst, b, h) do { _Pragma("unroll") for (int n = 0; n < 2; ++n) _Pragma("unroll") for (int k = 0; k < 2; ++k) dst[n][k] = *(const PG8_LAS bf16x8*)(lds + PG8_SB(b, h) + boff + n * 2048 + k * 1024); } while (0)
#define PG8_MMA(ai, bj, At, Bt) do { __builtin_amdgcn_s_setprio(1); _Pragma("unroll") for (int m = 0; m < 4; ++m) _Pragma("unroll") for (int n = 0; n < 2; ++n) _Pragma("unroll") for (int k = 0; k < 2; ++k) \
        acc[ai][bj][m][n] = __builtin_amdgcn_mfma_f32_16x16x32_bf16(Bt[n][k], At[m][k], acc[ai][bj][m][n], 0, 0, 0); __builtin_amdgcn_s_setprio(0); } while (0)
#define PG8_WAIT_V(n) asm volatile("s_waitcnt vmcnt(" #n ")" ::: "memory")
#define PG8_WAIT_L(n) asm volatile("s_waitcnt lgkmcnt(" #n ")" ::: "memory")
#define PG8_BAR __builtin_amdgcn_s_barrier()
#define PG8_SCHED __builtin_amdgcn_sched_barrier(0)
    Unit cur, nxt; int ui = 0;
    if (!S.next(0, cur)) return;
    f32x4 acc[2][2][4][2];
#pragma unroll
    for (int a = 0; a < 2; ++a)
#pragma unroll
        for (int b = 0; b < 2; ++b)
#pragma unroll
            for (int m = 0; m < 4; ++m)
#pragma unroll
                for (int n = 0; n < 2; ++n) acc[a][b][m][n] = (f32x4){0.f, 0.f, 0.f, 0.f};
    bf16x8 At[4][2], B0[2][2], B1[2][2];
    const char* cA = (const char*)(cur.seg ? g.A1 : g.A0) + (size_t)cur.pm * tstep; const char* cB = (const char*)(cur.seg ? g.B1 : g.B0) + (size_t)cur.pn * tstep;
    S.a_ready(cur);
    if constexpr (SP2) {
        PG8_STAGE(PG8_SB(0, 0), cB, voffB); PG8_STAGE(PG8_SB(0, 1), cB + hstep, voffB); PG8_STAGE(PG8_SA(0, 0), cA, voffA); PG8_STAGE(PG8_SA(0, 1), cA + hstep, voffA);
        if (wr == 1) PG8_BAR;
        PG8_WAIT_V(2); PG8_BAR;
        PG8_STAGE(PG8_SB(1, 0), cB + kstep, voffB); PG8_STAGE(PG8_SA(1, 0), cA + kstep, voffA); PG8_STAGE(PG8_SB(1, 1), cB + hstep + kstep, voffB);
        PG8_WAIT_V(6); PG8_BAR;
    } else {
        PG8_STAGE(PG8_SB(0, 0), cB, voffB); PG8_STAGE(PG8_SA(0, 0), cA, voffA); PG8_STAGE(PG8_SB(0, 1), cB + hstep, voffB); PG8_STAGE(PG8_SA(0, 1), cA + hstep, voffA);
        if (wr == 1) PG8_BAR;
        PG8_WAIT_V(4); PG8_BAR;
        PG8_STAGE(PG8_SB(1, 0), cB + kstep, voffB); PG8_STAGE(PG8_SA(1, 0), cA + kstep, voffA); PG8_STAGE(PG8_SB(1, 1), cB + hstep + kstep, voffB);
        PG8_WAIT_V(6); PG8_BAR;
    }
    for (;;) {
        const bool has_next = S.next(ui + 1, nxt);
        const char* nA = has_next ? (const char*)(nxt.seg ? g.A1 : g.A0) + (size_t)nxt.pm * tstep : cA; const char* nB = has_next ? (const char*)(nxt.seg ? g.B1 : g.B0) + (size_t)nxt.pn * tstep : cB;
        for (int t = 0; t < nt; t += 2) {
            const bool last = (t == nt - 2);
            const char* a1 = cA + (size_t)(t + 1) * kstep;
            const char* a2 = last ? nA : cA + (size_t)(t + 2) * kstep; const char* b2 = last ? nB : cB + (size_t)(t + 2) * kstep;
            const char* a3 = a2 + kstep; const char* b3 = b2 + kstep;
            if (last && has_next) S.a_ready(nxt);
            if constexpr (SP2) {
            PG8_LDB(B0, 0, 0); PG8_LDB(B1, 0, 1); PG8_SCHED; PG8_LDA(At, 0, 0); PG8_STAGE(PG8_SA(1, 1), a1 + hstep, voffA);
            PG8_WAIT_V(8); PG8_WAIT_L(0); PG8_BAR; PG8_MMA(0, 0, At, B0); PG8_MMA(0, 1, At, B1); PG8_BAR; PG8_SCHED;
            PG8_LDA(At, 0, 1); PG8_STAGE(PG8_SB(0, 0), b2, voffB); PG8_STAGE(PG8_SB(0, 1), b2 + hstep, voffB); PG8_STAGE(PG8_SA(0, 0), a2, voffA);
            PG8_WAIT_V(8); PG8_WAIT_L(0); PG8_BAR; PG8_MMA(1, 0, At, B0); PG8_MMA(1, 1, At, B1); PG8_BAR; PG8_SCHED;
            PG8_LDB(B0, 1, 0); PG8_LDB(B1, 1, 1); PG8_SCHED; PG8_LDA(At, 1, 0); PG8_STAGE(PG8_SA(0, 1), a2 + hstep, voffA);
            PG8_WAIT_V(8); PG8_WAIT_L(0); PG8_BAR; PG8_MMA(0, 0, At, B0); PG8_MMA(0, 1, At, B1); PG8_BAR; PG8_SCHED;
            PG8_LDA(At, 1, 1); PG8_STAGE(PG8_SB(1, 0), b3, voffB); PG8_STAGE(PG8_SB(1, 1), b3 + hstep, voffB); PG8_STAGE(PG8_SA(1, 0), a3, voffA);
            PG8_WAIT_V(8); PG8_WAIT_L(0); PG8_BAR; PG8_MMA(1, 0, At, B0); PG8_MMA(1, 1, At, B1); PG8_BAR; PG8_SCHED;
            } else {
            PG8_LDB(B0, 0, 0); PG8_SCHED; PG8_LDA(At, 0, 0); PG8_STAGE(PG8_SA(1, 1), a1 + hstep, voffA);
            PG8_WAIT_L(8); PG8_BAR; PG8_WAIT_L(0); PG8_MMA(0, 0, At, B0); PG8_BAR; PG8_SCHED;
            PG8_LDB(B1, 0, 1); PG8_STAGE(PG8_SB(0, 0), b2, voffB);
            PG8_BAR; PG8_WAIT_L(0); PG8_MMA(0, 1, At, B1); PG8_BAR;
            PG8_LDA(At, 0, 1); PG8_STAGE(PG8_SA(0, 0), a2, voffA);
            PG8_BAR; PG8_WAIT_L(0); PG8_MMA(1, 0, At, B0); PG8_BAR; PG8_SCHED;
            PG8_STAGE(PG8_SB(0, 1), b2 + hstep, voffB);
            PG8_WAIT_V(6); PG8_BAR; PG8_MMA(1, 1, At, B1); PG8_BAR;
            PG8_LDB(B0, 1, 0); PG8_SCHED; PG8_LDA(At, 1, 0); PG8_STAGE(PG8_SA(0, 1), a2 + hstep, voffA);
            PG8_WAIT_L(8); PG8_BAR; PG8_WAIT_L(0); PG8_MMA(0, 0, At, B0); PG8_BAR; PG8_SCHED;
            PG8_LDB(B1, 1, 1); PG8_STAGE(PG8_SB(1, 0), b3, voffB);
            PG8_BAR; PG8_WAIT_L(0); PG8_MMA(0, 1, At, B1); PG8_BAR;
            PG8_LDA(At, 1, 1); PG8_STAGE(PG8_SA(1, 0), a3, voffA);
            PG8_BAR; PG8_WAIT_L(0); PG8_MMA(1, 0, At, B0); PG8_BAR; PG8_SCHED;
            PG8_STAGE(PG8_SB(1, 1), b3 + hstep, voffB);
            PG8_WAIT_V(6); PG8_BAR; PG8_MMA(1, 1, At, B1); PG8_BAR;
            }
        }
        if constexpr (ALIGN_EPI) { if (wr == 0) PG8_BAR; }
        if constexpr (!Epi::AFTER_DRAIN) { E(acc, cur, wr, wc, fr, fq); S.done(cur); }
        if (!has_next) break;
        if (!(Epi::KEEP && cur.seg == 0)) {
#pragma unroll
        for (int a = 0; a < 2; ++a)
#pragma unroll
            for (int b = 0; b < 2; ++b)
#pragma unroll
                for (int m = 0; m < 4; ++m)
#pragma unroll
                    for (int n = 0; n < 2; ++n) acc[a][b][m][n] = (f32x4){0.f, 0.f, 0.f, 0.f};
        }
        cur = nxt; cA = nA; cB = nB; ++ui;
        if constexpr (ALIGN_EPI) { if (wr == 1) PG8_BAR; }
    }
    PG8_WAIT_V(0);
    if constexpr (!ALIGN_EPI) { if (wr == 0) PG8_BAR; }
    PG8_BAR;
    if constexpr (Epi::AFTER_DRAIN) { E.fused(acc, cur, wr, wc, fr, fq, lds, wid, lane); S.done(cur); }
#undef PG8_SA
#undef PG8_SB
#undef PG8_STAGE
#undef PG8_LDA
#undef PG8_LDB
#undef PG8_MMA
#undef PG8_WAIT_V
#undef PG8_WAIT_L
#undef PG8_BAR
#undef PG8_SCHED
}
}


namespace att {
#define ATT_LAS __attribute__((address_space(3)))
typedef unsigned short bf16_t;
typedef short bf16x8 __attribute__((ext_vector_type(8)));
typedef short s16x4 __attribute__((ext_vector_type(4)));
typedef float f32x16 __attribute__((ext_vector_type(16)));
typedef unsigned u32x4 __attribute__((ext_vector_type(4)));
typedef float f32x2_t __attribute__((ext_vector_type(2))); typedef __bf16 bf16x2_t __attribute__((ext_vector_type(2)));
constexpr int SEQ = 4096, PITCH = 512, NW = 8, QBLK = 32, QB = QBLK * NW, KVBLK = 64;
constexpr int NSLOT = 3, SLOTB = 32768, OFF_K1 = 8192, OFF_V = 16384, LDS_BYTES = NSLOT * SLOTB;
constexpr int QB2 = 128;
__device__ __forceinline__ int crow(int r, int hi) { return (r & 3) + 8 * (r >> 2) + 4 * hi; }
__device__ __forceinline__ void glds16(const void* gsrc, unsigned lds_dst) { unsigned keep;
    asm volatile("s_mov_b32 %0, m0\n\ts_mov_b32 m0, %2\n\ts_nop 0\n\tglobal_load_lds_dwordx4 %1, off\n\ts_mov_b32 m0, %0" : "=&s"(keep) : "v"(gsrc), "s"(lds_dst) : "memory"); }
__device__ __forceinline__ unsigned cvtpk_s(float lo, float hi) { f32x2_t v = {lo, hi}; bf16x2_t b = __builtin_convertvector(v, bf16x2_t); return __builtin_bit_cast(unsigned, b); }
typedef ATT_LAS const char* lds_cptr;
typedef short v4i16_t __attribute__((ext_vector_type(4)));
__device__ __forceinline__ s16x4 vtr(lds_cptr p) { return __builtin_bit_cast(s16x4, __builtin_amdgcn_ds_read_tr16_b64_v4i16((ATT_LAS v4i16_t*)p)); }
#define ATT_WAIT_BAR(N) asm volatile("s_waitcnt vmcnt(" #N ") lgkmcnt(0)\n\ts_barrier" ::: "memory")

__device__ __forceinline__ void attn_unit(const int b, const int h, const int qb, const bf16_t* Q, const bf16_t* K, const bf16_t* V, bf16_t* O, ATT_LAS char* shm, const float lam) {
    const int tid = threadIdx.x, lane = tid & 63, r32 = lane & 31, hi = lane >> 5; const int wid = __builtin_amdgcn_readfirstlane(tid >> 6), sub = wid >> 2, w4 = wid & 3;
    const long rowbase = (long)b * SEQ; const int q0 = qb * QB2;
    const bf16_t* Qw = Q + (rowbase + q0 + w4 * QBLK) * PITCH + h * 128 + sub * 64;
    const bf16_t* Kh = K + rowbase * PITCH + h * 128; const bf16_t* Vh = V + rowbase * PITCH + h * 128;
    const unsigned lds0 = (unsigned)(uintptr_t)shm;
    const bf16_t* ksrc = Kh + (long)lane * PITCH + wid * 8;
    const bf16_t* vsrc = Vh + (long)(16 * (wid & 3) + (lane >> 2)) * PITCH + (wid >> 2) * 32 + (lane & 3) * 8;
    const unsigned pdst = lds0 + wid * 1024;
#define DMA_T(t, s) do { const long go_ = (long)(t) * KVBLK * PITCH; const unsigned sd_ = (unsigned)__builtin_amdgcn_readfirstlane(pdst + (s) * SLOTB); \
        glds16(ksrc + go_, sd_); glds16(ksrc + go_ + 64, sd_ + OFF_K1); glds16(vsrc + go_, sd_ + OFF_V); glds16(vsrc + go_ + 64, sd_ + OFF_V + 8192); } while (0)
    const lds_cptr kp0 = (lds_cptr)shm + sub * OFF_K1 + hi * 1024 + r32 * 16;
    const lds_cptr vp0 = (lds_cptr)shm + OFF_V + ((lane >> 4) & 1) * 32 + (lane & 3) * 8 + (4 * hi + ((lane & 15) >> 2)) * 64;
    const int NT = (q0 + QB2) / KVBLK;
    const int mylast = q0 / KVBLK + (w4 >> 1);
    DMA_T(0, 0); DMA_T(1, 1);
    bf16x8 qr[4];
#pragma unroll
    for (int d0 = 0; d0 < 4; ++d0) qr[d0] = *reinterpret_cast<const bf16x8*>(&Qw[(long)r32 * PITCH + d0 * 16 + hi * 8]);
    asm volatile("" : "+v"(qr[0]), "+v"(qr[1]), "+v"(qr[2]), "+v"(qr[3]));
    f32x16 o[4]; o[0] = f32x16{}; o[1] = f32x16{}; o[2] = f32x16{}; o[3] = f32x16{};
    float l_reg = 0.f;
    int slot = 0, slot2 = 2;
    for (int t = 0; t < NT; ++t) {
        if (t + 1 < NT) { ATT_WAIT_BAR(4); } else { ATT_WAIT_BAR(0); }
        if (t + 2 < NT) DMA_T(t + 2, slot2);
        if (t <= mylast) {
            const lds_cptr kp = kp0 + slot * SLOTB; const lds_cptr vp = vp0 + slot * SLOTB;
#define ATT_SBAR() __builtin_amdgcn_sched_barrier(0)
#define ATT_VLOAD(dst, d0) do { _Pragma("unroll") for (int ks = 0; ks < 4; ++ks) { dst[2 * ks] = vtr(vp + (d0) * 4096 + ks * 1024); dst[2 * ks + 1] = vtr(vp + (d0) * 4096 + ks * 1024 + 512); } } while (0)
#define ATT_PV(acc, src) do { _Pragma("unroll") for (int ks = 0; ks < 4; ++ks) { const bf16x8 vf_ = (bf16x8){src[2 * ks][0], src[2 * ks][1], src[2 * ks][2], src[2 * ks][3], src[2 * ks + 1][0], src[2 * ks + 1][1], src[2 * ks + 1][2], src[2 * ks + 1][3]}; \
                acc = __builtin_amdgcn_mfma_f32_32x32x16_bf16(__builtin_bit_cast(bf16x8, pw[ks]), vf_, acc, 0, 0, 0); } } while (0)
            bf16x8 kf[8]; s16x4 va[8], vb[8];
#pragma unroll
            for (int d0 = 0; d0 < 4; ++d0) { kf[2 * d0] = *(const ATT_LAS bf16x8*)(kp + d0 * 2048); kf[2 * d0 + 1] = *(const ATT_LAS bf16x8*)(kp + d0 * 2048 + 512); }
            ATT_VLOAD(va, 0);
            ATT_SBAR();
            f32x16 p0 = f32x16{}, p1 = f32x16{};
#pragma unroll
            for (int d0 = 0; d0 < 4; ++d0) { p0 = __builtin_amdgcn_mfma_f32_32x32x16_bf16(kf[2 * d0], qr[d0], p0, 0, 0, 0); p1 = __builtin_amdgcn_mfma_f32_32x32x16_bf16(kf[2 * d0 + 1], qr[d0], p1, 0, 0, 0); }
            ATT_SBAR();
            ATT_VLOAD(vb, 1);
            ATT_SBAR();
#pragma unroll
            for (int r = 0; r < 16; ++r) { p0[r] = __builtin_amdgcn_exp2f(p0[r]); p1[r] = __builtin_amdgcn_exp2f(p1[r]); }
            u32x4 pw[4];
#pragma unroll
            for (int j = 0; j < 4; ++j) { pw[0][j] = cvtpk_s(p0[2 * j], p0[2 * j + 1]); pw[1][j] = cvtpk_s(p0[8 + 2 * j], p0[9 + 2 * j]); pw[2][j] = cvtpk_s(p1[2 * j], p1[2 * j + 1]); pw[3][j] = cvtpk_s(p1[8 + 2 * j], p1[9 + 2 * j]); }
            { float sa = 0.f, sb = 0.f;
#pragma unroll
              for (int r = 0; r < 16; ++r) { sa += p0[r]; sb += p1[r]; }
              l_reg += sa + sb; }
            ATT_PV(o[0], va);
            ATT_SBAR();
            ATT_VLOAD(va, 2);
            ATT_SBAR();
            ATT_PV(o[1], vb);
            ATT_SBAR();
            ATT_VLOAD(vb, 3);
            ATT_SBAR();
            ATT_PV(o[2], va);
            ATT_SBAR();
            ATT_PV(o[3], vb);
#undef ATT_SBAR
#undef ATT_VLOAD
#undef ATT_PV
        }
        slot = (slot == NSLOT - 1) ? 0 : slot + 1; slot2 = (slot2 == NSLOT - 1) ? 0 : slot2 + 1;
    }
#undef DMA_T
    { auto rr = __builtin_amdgcn_permlane32_swap(__float_as_uint(l_reg), __float_as_uint(l_reg), false, false); l_reg = __uint_as_float(rr[0]) + __uint_as_float(rr[1]); }
    const float rl = __builtin_amdgcn_rcpf(l_reg);
    asm volatile("s_waitcnt vmcnt(0) lgkmcnt(0)\n\ts_barrier" ::: "memory");
    ATT_LAS float* xa = (ATT_LAS float*)shm + w4 * 4096 + lane;
    if (sub == 0) {
#pragma unroll
        for (int r = 0; r < 16; ++r) { const float rli = __shfl(rl, crow(r, hi));
#pragma unroll
            for (int d0 = 0; d0 < 4; ++d0) xa[(d0 * 16 + r) * 64] = o[d0][r] * rli; }
    }
    asm volatile("s_waitcnt lgkmcnt(0)\n\ts_barrier" ::: "memory");
    if (sub == 1) {
        ATT_LAS bf16_t* stg = (ATT_LAS bf16_t*)(shm + 65536 + w4 * 8192);
#pragma unroll
        for (int r = 0; r < 16; ++r) { const int rw = crow(r, hi); const float rli = __shfl(rl, rw) * lam;
            float v[4]; float ss = 0.f;
#pragma unroll
            for (int d0 = 0; d0 < 4; ++d0) { v[d0] = xa[(d0 * 16 + r) * 64] - o[d0][r] * rli; ss += v[d0] * v[d0]; }
            ss += __shfl_xor(ss, 1); ss += __shfl_xor(ss, 2); ss += __shfl_xor(ss, 4); ss += __shfl_xor(ss, 8); ss += __shfl_xor(ss, 16);
            const float rn = __builtin_amdgcn_rsqf(ss * (1.0f / 128.0f) + 1e-6f);
#pragma unroll
            for (int d0 = 0; d0 < 4; ++d0) stg[rw * 128 + d0 * 32 + r32] = (bf16_t)(cvtpk_s(v[d0] * rn, 0.f) & 0xffffu); }
        asm volatile("s_waitcnt lgkmcnt(0)" ::: "memory");
        bf16_t* obase = O + (rowbase + q0 + w4 * QBLK) * PITCH + h * 128;
#pragma unroll
        for (int i = 0; i < 8; ++i) { const int row = i * 4 + (lane >> 4), ch = lane & 15; const u32x4 w = *(const ATT_LAS u32x4*)(stg + row * 128 + ch * 8); *(u32x4*)(obase + (long)row * PITCH + ch * 8) = w; }
    }
    asm volatile("s_waitcnt vmcnt(0) lgkmcnt(0)\n\ts_barrier" ::: "memory");
}
#undef ATT_WAIT_BAR
}

constexpr int NWAVES = 8;
#ifndef MK_N_LAUNCHES
#define MK_N_LAUNCHES 1
#endif
constexpr int N_PHASES = 7;
constexpr int BATCH = 8, SEQ = 4096, D = 1024, M = BATCH * SEQ, DC = 512, NQK = 512, NV = 512, INC = 5120, FF = 2816, FF2 = 5632;
constexpr size_t MiB = 1u << 20;
constexpr size_t WS_CTL = 0, CTL_ZERO_BYTES = 16384;
constexpr size_t WS_COS = 1 * MiB, WS_SIN = 1 * MiB + 512 * 1024, WS_RS1 = 2 * MiB, WS_SS = 3 * MiB;
constexpr size_t WS_WIN = 8 * MiB, WS_WGU = 18 * MiB, WS_WDN = 29 * MiB, WS_WO = 36 * MiB, WS_WC = 38 * MiB, WS_WA = 39 * MiB;
constexpr size_t WS_XB = 40 * MiB;
constexpr size_t WS_O0 = 40 * MiB, WS_X1B = 40 * MiB;
constexpr size_t WS_BC = 104 * MiB, WS_U = 136 * MiB;
constexpr size_t WS_M1 = 104 * MiB;
constexpr size_t WS_Q = 168 * MiB, WS_K = 200 * MiB, WS_V = 232 * MiB;
constexpr size_t WS_G = 264 * MiB;
constexpr size_t WS_CM = 392 * MiB, WS_O = 424 * MiB;
constexpr size_t WS_ACT = 104 * MiB;
constexpr size_t WS_END = 456 * MiB;
static_assert(WS_ACT + (size_t)M * FF * 2 <= WS_CM && WS_G + (size_t)M * 2048 * 2 <= WS_CM && WS_O + (size_t)M * 512 * 2 <= WS_END, "d_ws map");

constexpr int LDS_BYTES = 147456, MISC_OFF = 131072 + 8192;
#define GAS __attribute__((address_space(1)))
#define LAS __attribute__((address_space(3)))
typedef unsigned short bf16;
typedef unsigned v4u __attribute__((ext_vector_type(4)));
typedef float f32x4 __attribute__((ext_vector_type(4)));
#define LDS_WAIT() asm volatile("s_waitcnt lgkmcnt(0)" ::: "memory")
__device__ __forceinline__ unsigned f2bf(float f) { unsigned u = __builtin_bit_cast(unsigned, f); return (u + 0x7fffu + ((u >> 16) & 1u)) >> 16; }
__device__ __forceinline__ unsigned pk2(float lo, float hi) { return f2bf(lo) | (f2bf(hi) << 16); }
__device__ __forceinline__ float wave_sum(float v) {
#pragma unroll
    for (int o = 1; o < 64; o <<= 1) v += __shfl_xor(v, o);
    return v;
}
__device__ __forceinline__ float wave_max(float v) {
#pragma unroll
    for (int o = 1; o < 64; o <<= 1) v = fmaxf(v, __shfl_xor(v, o));
    return v;
}
__device__ __forceinline__ int dst_win(int n0) {
    if (n0 < 512) return n0;
    if (n0 < 1024) { const int ch = n0 - 512; return 512 + 256 * (ch >> 7) + (ch & 127); }
    if (n0 < 1536) { const int ch = n0 - 1024; return 512 + 256 * (ch >> 7) + 128 + (ch & 127); }
    if (n0 < 2560) { const int off = n0 - 1536, tile = off >> 8, w = off & 255, wc = w >> 6, bj = (w & 63) >> 5; return 1536 + 256 * tile + 128 * bj + 32 * wc; }
    if (n0 < 3072) return n0;
    if (n0 < 4096) { const int c = n0 - 3072; return 3072 + 256 * (c >> 7) + (c & 127); }
    { const int c = n0 - 4096; return 3072 + 256 * (c >> 7) + 128 + (c & 127); }
}
__device__ __forceinline__ int dst_wgu(int n0) { if (n0 < FF) return 256 * (n0 >> 7) + (n0 & 127); const int n = n0 - FF; return 256 * (n >> 7) + 128 + (n & 127); }
template <int MAP> __device__ __forceinline__ void p0_transpose_item(const float* W, int K, int N, bf16* WT, const float* kscale, int kmask, float cs, LAS float* scr, int item, int lane) {
    const int nblk = N / 32, kb = item / nblk, nb = item % nblk, k0 = 64 * kb, n0 = 32 * nb;
    const int d0 = (MAP == 1) ? dst_win(n0) : (MAP == 2) ? dst_wgu(n0) : n0;
#pragma unroll
    for (int i = 0; i < 32; ++i) { const int kk = 2 * i + (lane >> 5); const float s = kscale ? kscale[(k0 + kk) & kmask] * cs : cs; scr[kk * 33 + (lane & 31)] = __builtin_nontemporal_load(W + (size_t)(k0 + kk) * N + n0 + (lane & 31)) * s; }
    LDS_WAIT(); asm volatile("" ::: "memory");
    const int c = lane & 7;
#pragma unroll
    for (int j = 0; j < 4; ++j) { const int n = (lane >> 3) + 8 * j; const LAS float* s = scr + (8 * c) * 33 + n;
        v4u o; o.x = pk2(s[0 * 33], s[1 * 33]); o.y = pk2(s[2 * 33], s[3 * 33]); o.z = pk2(s[4 * 33], s[5 * 33]); o.w = pk2(s[6 * 33], s[7 * 33]);
        *(GAS v4u*)(WT + (size_t)(d0 + n) * K + k0 + 8 * c) = o; }
    LDS_WAIT(); asm volatile("" ::: "memory");
}

typedef GAS unsigned gu32;
#define XB_TMO      128
#define XB_XCNT(j)  (256  + 64 * (j))
#define XB_XSUB(j)  (1280 + 64 * (j))
#define XB_XGEN(j)  (2304 + 64 * (j))
#define XB_TOP      3328
#define XB_TOPGEN   3392
#define XCD_BAR_WORDS 3456
#define XB_SPIN_CAP (1u << 18)

__device__ __forceinline__ unsigned xb_ld(unsigned* p)              { return __hip_atomic_load(p, __ATOMIC_RELAXED, __HIP_MEMORY_SCOPE_AGENT); }
__device__ __forceinline__ unsigned xb_add(unsigned* p, unsigned v) { return __hip_atomic_fetch_add(p, v, __ATOMIC_RELAXED, __HIP_MEMORY_SCOPE_AGENT); }
__device__ __forceinline__ unsigned xb_xcc_id() { return (unsigned)__builtin_amdgcn_s_getreg((3 << 11) | 20) & 0xFu; }
#define XB_SPIN(cond, bar) do { unsigned _sp = 0; while (cond) { __builtin_amdgcn_s_sleep(1); \
    if ((++_sp & 255u) == 0u) { if (xb_ld(&(bar)[XB_TMO])) break; if (_sp > XB_SPIN_CAP) { atomicAdd(&(bar)[XB_TMO], 1u); break; } } } } while (0)

struct XcdBarrier {
    unsigned* bar; unsigned x;
    volatile LAS unsigned* st;
};

__device__ __forceinline__ XcdBarrier xcd_barrier_post(unsigned* bar, volatile LAS unsigned* st) {
    XcdBarrier b; b.bar = bar; b.x = xb_xcc_id(); b.st = st;
    if (threadIdx.x == 0) (void)xb_add(&bar[XB_XCNT(b.x)], 1u);
    return b;
}
__device__ __forceinline__ void xcd_barrier_complete(unsigned* bar, unsigned x, unsigned& nloc, unsigned& nx) {
    const unsigned G = gridDim.x * gridDim.y * gridDim.z;
    unsigned sum, cnt, mine, sp = 0u;
    for (;;) {
        sum = 0u; cnt = 0u; mine = 0u;
#pragma unroll
        for (unsigned j = 0; j < 16; ++j) { const unsigned c = xb_ld(&bar[XB_XCNT(j)]); sum += c; cnt += (c > 0u) ? 1u : 0u; mine = (j == x) ? c : mine; }
        if (sum == G) break;
        __builtin_amdgcn_s_sleep(1);
        if ((++sp & 255u) == 0u) { if (xb_ld(&bar[XB_TMO])) break; if (sp > XB_SPIN_CAP) { atomicAdd(&bar[XB_TMO], 1u); break; } }
    }
    nloc = mine > 0u ? mine : 1u; nx = cnt > 0u ? cnt : 1u;
}

__device__ __forceinline__ void xcd_barrier(const XcdBarrier& b) {
    asm volatile("s_waitcnt vmcnt(0)" ::: "memory");
    __syncthreads();
    if (threadIdx.x == 0) {
        unsigned* bar = b.bar;
        __builtin_amdgcn_s_waitcnt(0);
        unsigned nloc = b.st[0], nx = b.st[1];
        if (nloc == 0u) { xcd_barrier_complete(bar, b.x, nloc, nx); b.st[0] = nloc; b.st[1] = nx; }
        const unsigned old = xb_add(&bar[XB_XSUB(b.x)], 1u);
        const unsigned gen = old / nloc;
        if (old + 1u == (gen + 1u) * nloc) {
            __builtin_amdgcn_fence(__ATOMIC_RELEASE, "agent");
            asm volatile("s_waitcnt vmcnt(0)" ::: "memory");
            const unsigned og = xb_add(&bar[XB_TOP], 1u);
            const unsigned tg = og / nx;
            if (og + 1u == (tg + 1u) * nx) xb_add(&bar[XB_TOPGEN], 1u);
            else XB_SPIN(xb_ld(&bar[XB_TOPGEN]) == tg, bar);
            __builtin_amdgcn_fence(__ATOMIC_ACQUIRE, "agent");
            xb_add(&bar[XB_XGEN(b.x)], 1u);
            asm volatile("s_waitcnt vmcnt(0)" ::: "memory");
        } else {
            XB_SPIN(xb_ld(&bar[XB_XGEN(b.x)]) == gen, bar);
            __builtin_amdgcn_fence(__ATOMIC_ACQUIRE, "agent");
            asm volatile("s_waitcnt vmcnt(0)" ::: "memory");
        }
    }
    __syncthreads();
}

#define LB_SUB(j) (XCD_BAR_WORDS + 64 + 64 * (j))
#define LB_GEN(j) (XCD_BAR_WORDS + 64 + 512 + 64 * (j))
#define G_BAR_WORDS (XCD_BAR_WORDS + 64 + 1024)
__device__ unsigned g_bar[G_BAR_WORDS];
__device__ __forceinline__ void xcd_local_barrier(const XcdBarrier& b) {
    asm volatile("s_waitcnt vmcnt(0)" ::: "memory");
    __syncthreads();
    if (threadIdx.x == 0) {
        __builtin_amdgcn_s_waitcnt(0);
        unsigned* bar = b.bar;
        const unsigned old = xb_add(&bar[LB_SUB(b.x)], 1u), gen = old / 32u;
        if (old + 1u == (gen + 1u) * 32u) xb_add(&bar[LB_GEN(b.x)], 1u);
        else XB_SPIN(xb_ld(&bar[LB_GEN(b.x)]) == gen, bar);
        __builtin_amdgcn_fence(__ATOMIC_ACQUIRE, "agent");
        asm volatile("s_waitcnt vmcnt(0)" ::: "memory");
    }
    __syncthreads();
}
struct Args { const float* in[18]; float* out; unsigned char* ws; int ph_lo, ph_hi; };
enum { I_X = 0, I_GMIX, I_WIN, I_BGATE, I_CONVW, I_QN, I_KN, I_LQ1, I_LK1, I_LQ2, I_LK2, I_SUBN, I_WCO, I_WAO, I_WO, I_GFFN, I_WGU, I_WDN };

__global__ void __launch_bounds__(NWAVES * 64, 2) hybrid_fwd(Args args) {
    extern __shared__ __attribute__((aligned(16))) unsigned char lds[];
    LAS unsigned char* L = (LAS unsigned char*)lds;
    const int tid = threadIdx.x, lane = tid & 63, wave = __builtin_amdgcn_readfirstlane(tid >> 6);
    const int G = gridDim.x, bx = blockIdx.x, vcu = (G % 8 == 0) ? (bx % 8) * (G / 8) + bx / 8 : bx;
    unsigned char* ws = args.ws;
    const float* x = args.in[I_X]; float* out = args.out;
    bf16 *Win = (bf16*)(ws + WS_WIN), *Wgu = (bf16*)(ws + WS_WGU), *Wdn = (bf16*)(ws + WS_WDN), *Wo = (bf16*)(ws + WS_WO), *Wc = (bf16*)(ws + WS_WC), *Wa = (bf16*)(ws + WS_WA);
    bf16 *XB = (bf16*)(ws + WS_XB), *X1B = (bf16*)(ws + WS_X1B), *BC = (bf16*)(ws + WS_BC), *U = (bf16*)(ws + WS_U), *M1 = (bf16*)out  ;
    bf16 *Qb = (bf16*)(ws + WS_Q), *Kb = (bf16*)(ws + WS_K), *Vb = (bf16*)(ws + WS_V), *Gb = (bf16*)(ws + WS_G), *CM = (bf16*)(ws + WS_CM), *Ob = (bf16*)(ws + WS_O), *ACT = (bf16*)(ws + WS_ACT);
    float *O0 = out  , *RS1 = (float*)(ws + WS_RS1), *SS = (float*)(ws + WS_SS), *COS = (float*)(ws + WS_COS), *SIN = (float*)(ws + WS_SIN);
    const int lo = args.ph_lo, hi = args.ph_hi;
    volatile LAS unsigned* MISC = (volatile LAS unsigned*)(L + MISC_OFF);
    if (tid < 32) MISC[tid] = 0u;
    __syncthreads();
    XcdBarrier bar; bar.bar = g_bar; bar.x = xb_xcc_id(); bar.st = MISC + 8;
    if (tid == 0) MISC[2] = xb_add(&g_bar[XB_XCNT(bar.x)], 1u);
    if (hi > 1000) cg::this_grid().sync();
#define IN(k) (lo <= (k) && (k) < hi)
#define SEAM(k) do { if (IN(k) && IN((k) + 1)) xcd_barrier(bar); } while (0)

    if (IN(0)) {
        LAS float* scr = (LAS float*)(L + wave * 16384);
        const int gw = vcu * NWAVES + wave, NGW = G * NWAVES;
        constexpr int I_1 = (D / 64) * (INC / 32), I_2 = (D / 64) * (FF2 / 32), I_3 = (FF / 64) * (D / 32), I_4 = (D / 64) * (D / 32), I_5 = (DC / 64) * (D / 32), I_6 = I_5;
        constexpr int NITEMS = I_1 + I_2 + I_3 + I_4 + I_5 + I_6;
        for (int it = gw; it < NITEMS; it += NGW) {
            int r = it;
            if (r < I_1) { p0_transpose_item<1>(args.in[I_WIN], D, INC, Win, args.in[I_GMIX], 0x7fffffff, 1.0f, scr, r, lane); continue; } r -= I_1;
            if (r < I_2) { p0_transpose_item<2>(args.in[I_WGU], D, FF2, Wgu, args.in[I_GFFN], 0x7fffffff, 1.0f, scr, r, lane); continue; } r -= I_2;
            if (r < I_3) { p0_transpose_item<0>(args.in[I_WDN], FF, D, Wdn, nullptr, 0, 1.0f, scr, r, lane); continue; } r -= I_3;
            if (r < I_4) { p0_transpose_item<0>(args.in[I_WO], D, D, Wo, nullptr, 0, 1.0f, scr, r, lane); continue; } r -= I_4;
            if (r < I_5) { p0_transpose_item<0>(args.in[I_WCO], DC, D, Wc, nullptr, 0, 1.0f, scr, r, lane); continue; } r -= I_5;
            p0_transpose_item<0>(args.in[I_WAO], NV, D, Wa, args.in[I_SUBN], 127, 0.8f, scr, r, lane);
        }
        for (int m0 = gw * 4; m0 < M; m0 += NGW * 4) {
            f32x4 v[4][4]; float s2[4];
#pragma unroll
            for (int r = 0; r < 4; ++r) { const GAS f32x4* xr = (const GAS f32x4*)(x + (size_t)(m0 + r) * D) + lane;
#pragma unroll
                for (int j = 0; j < 4; ++j) v[r][j] = __builtin_nontemporal_load(xr + 64 * j); }
#pragma unroll
            for (int r = 0; r < 4; ++r) { float a = 0.f;
#pragma unroll
                for (int j = 0; j < 4; ++j) a += (v[r][j].x * v[r][j].x + v[r][j].y * v[r][j].y) + (v[r][j].z * v[r][j].z + v[r][j].w * v[r][j].w);
                s2[r] = wave_sum(a) * (1.0f / D) + 1e-6f;
                const float rstd = 1.0f / sqrtf(s2[r]);
                GAS unsigned long long* o8 = (GAS unsigned long long*)(XB + (size_t)(m0 + r) * D) + lane;
#pragma unroll
                for (int j = 0; j < 4; ++j) o8[64 * j] = (unsigned long long)pk2(v[r][j].x * rstd, v[r][j].y * rstd) | ((unsigned long long)pk2(v[r][j].z * rstd, v[r][j].w * rstd) << 32); }
            if (lane < 4) SS[m0 + lane] = 0.f;
            if (lane < 4) RS1[m0 + lane] = sqrtf(lane == 0 ? s2[0] : lane == 1 ? s2[1] : lane == 2 ? s2[2] : s2[3]);
        }
        for (int e = vcu * 512 + tid; e < SEQ * 32; e += G * 512) {
            const int pos = e >> 5, i = e & 31;
            const float inv = __builtin_amdgcn_exp2f(-(float)i * (13.287712379549449f / 32.0f)); const float ang = (float)pos * inv;
            const double rv = (double)ang * 0.15915494309189535; const float fr = (float)(rv - __builtin_rint(rv));
            ((unsigned*)COS)[e] = pk2(__builtin_amdgcn_cosf(fr), __builtin_amdgcn_sinf(fr));
        }
    }
    SEAM(0);
    if (tid == 0) { unsigned okc = (G == 256 && IN(0) && IN(6)) ? 1u : 0u;
        for (unsigned j = 0; j < 16; ++j) { const unsigned c = xb_ld(&g_bar[XB_XCNT(j)]); if (c != (j < 8 ? 32u : 0u)) okc = 0u; }
        MISC[3] = okc; }
    __syncthreads();
    const bool xok = MISC[3] != 0u;
    const int vbx = xok ? (int)(bar.x + 8u * MISC[2]) : bx, vcu2 = xok ? (int)(bar.x * 32u + MISC[2]) : vcu;
#define SEAML(k) do { if (IN(k) && IN((k) + 1)) { if (xok) xcd_local_barrier(bar); else xcd_barrier(bar); } } while (0)

    if (IN(1)) {
        pg8::Gemm g{XB, XB, Win, Win, M, INC, D}; pg8::StaticOrder S; S.init(M, INC, G, vbx);
        pg8::EpiInProj E{BC, U, Qb, Kb, Vb, Gb, args.in[I_BGATE], args.in[I_QN], args.in[I_KN], COS, SIN};
        pg8::gemm_phase<pg8::EpiInProj, pg8::StaticOrder, true, true>(L, g, S, E);
    }
    SEAML(1);

    if (IN(2)) {
        {
            const float* cw = args.in[I_CONVW];
            for (int it = vcu2 * 512 + tid; it < (M / 16) * 64; it += G * 512) {
                const int cg8 = it & 63, r0 = (it >> 6) * 16, c0 = cg8 * 8, t0 = r0 & (SEQ - 1);
                f32x4 w0a = *(const f32x4*)(cw + c0), w0b = *(const f32x4*)(cw + c0 + 4), w1a = *(const f32x4*)(cw + 512 + c0), w1b = *(const f32x4*)(cw + 512 + c0 + 4), w2a = *(const f32x4*)(cw + 1024 + c0), w2b = *(const f32x4*)(cw + 1024 + c0 + 4);
                f32x4 um2a = {0.f, 0.f, 0.f, 0.f}, um2b = um2a, um1a = um2a, um1b = um2a;
                if (t0 >= 2) { pg8::load8nt(U + (size_t)(r0 - 2) * 512 + c0, um2a, um2b); pg8::load8nt(U + (size_t)(r0 - 1) * 512 + c0, um1a, um1b); }
#pragma unroll 4
                for (int i = 0; i < 16; ++i) { const size_t o = (size_t)(r0 + i) * 512 + c0; f32x4 ua, ub, ba, bb; pg8::load8nt(U + o, ua, ub); pg8::load8nt(BC + o, ba, bb);
                    const f32x4 ya = ba * (w0a * um2a + w1a * um1a + w2a * ua), yb = bb * (w0b * um2b + w1b * um1b + w2b * ub);
                    pg8::store8(CM + o, ya, yb); um2a = um1a; um2b = um1b; um1a = ua; um1b = ub; }
            }
        }
        const float lq1 = args.in[I_LQ1][lane] * args.in[I_LK1][lane], lq2 = args.in[I_LQ2][lane] * args.in[I_LK2][lane];
        const float lam = expf(wave_sum(lq1)) - expf(wave_sum(lq2)) + 0.2f;
        __syncthreads();
        if (G == 256) {
            const int xg = vcu2 >> 5, j = vcu2 & 31;
            for (int r = 0; r < 4; ++r) { const int bh = xg * 4 + r, qb = (r & 1) ? 31 - j : j; att::attn_unit(bh >> 2, bh & 3, qb, Qb, Kb, Vb, Ob, (LAS char*)L, lam); }
        } else {
            for (int u = vcu2; u < 1024; u += G) { const int bh = u >> 5, qb = u & 31; att::attn_unit(bh >> 2, bh & 3, qb, Qb, Kb, Vb, Ob, (LAS char*)L, lam); }
        }
    }
    SEAML(2);

    if (IN(3)) {
        pg8::Gemm g{CM, Ob, Wc, Wa, M, D, DC}; pg8::DualOrder S; S.init(M, D, G, vbx);
        pg8::EpiDual E{Gb, M1};
        pg8::gemm_phase<pg8::EpiDual, pg8::DualOrder, true, true>(L, g, S, E);
    }
    SEAML(3);

    if (IN(4)) {
        pg8::Gemm g{M1, M1, Wo, Wo, M, D, D}; pg8::StaticOrder S; S.init(M, D, G, vbx);
        pg8::EpiX1 E{X1B, RS1, SS};
        pg8::gemm_phase<pg8::EpiX1, pg8::StaticOrder, true, true>(L, g, S, E);
    }
    SEAM(4);

    if (IN(5)) {
        pg8::Gemm g{X1B, X1B, Wgu, Wgu, M, FF2, D}; pg8::StaticOrder S; S.init(M, FF2, G, vbx);
        pg8::EpiGateUp E{SS, ACT};
        pg8::gemm_phase<pg8::EpiGateUp, pg8::StaticOrder, true, true>(L, g, S, E);
    }
    SEAML(5);

    if (IN(6)) {
        pg8::Gemm g{ACT, ACT, Wdn, Wdn, M, D, FF}; pg8::StaticOrder S; S.init(M, D, G, vbx);
        pg8::EpiDown E{X1B, out};
        pg8::gemm_phase<pg8::EpiDown, pg8::StaticOrder, true, true>(L, g, S, E);
    }
    if (lo == 0 && hi == N_PHASES) {
        __syncthreads();
        if (tid == 0) MISC[0] = (xb_add(&g_bar[XCD_BAR_WORDS], 1u) == (unsigned)G - 1u) ? 1u : 0u;
        __syncthreads();
        if (MISC[0]) for (int i = tid; i < G_BAR_WORDS; i += NWAVES * 64) g_bar[i] = 0u;
    }
#undef IN
#undef SEAM
#undef SEAML
}

extern "C" void kernel_launch(void* const* d_in, const int* in_sizes, int n_in, void* d_out, int out_size, void* d_ws, size_t ws_size, hipStream_t stream) {
    static int grid = 0;
    if (grid == 0) {
        if (n_in != 18 || in_sizes[0] != M * D || out_size != M * D || ws_size < WS_END) { fprintf(stderr, "kernel_launch: unexpected shapes (n_in %d, in0 %d, out %d, ws %zu); nothing launched\n", n_in, n_in > 0 ? in_sizes[0] : -1, out_size, ws_size); grid = -1; return; }
        int dev = 0, cus = 0, per_cu = 0;
        if (hipGetDevice(&dev) != hipSuccess || hipDeviceGetAttribute(&cus, hipDeviceAttributeMultiprocessorCount, dev) != hipSuccess) { grid = -1; return; }
        if (hipFuncSetAttribute((const void*)hybrid_fwd, hipFuncAttributeMaxDynamicSharedMemorySize, LDS_BYTES) != hipSuccess) { fprintf(stderr, "kernel_launch: hipFuncSetAttribute failed\n"); grid = -1; return; }
        if (hipOccupancyMaxActiveBlocksPerMultiprocessor(&per_cu, (const void*)hybrid_fwd, NWAVES * 64, LDS_BYTES) != hipSuccess || per_cu < 1) { fprintf(stderr, "kernel_launch: occupancy query gives %d\n", per_cu); per_cu = 1; }
        (void)hipGetLastError();
        grid = cus * 1;
    }
    if (grid < 0) return;
    Args a{};
    for (int i = 0; i < 18; ++i) a.in[i] = (const float*)d_in[i];
    a.out = (float*)d_out; a.ws = (unsigned char*)d_ws;
#if MK_N_LAUNCHES == 1
    a.ph_lo = 0; a.ph_hi = N_PHASES;
    void* kargs[] = {&a};
    hipError_t e = hipLaunchCooperativeKernel((const void*)hybrid_fwd, dim3(grid), dim3(NWAVES * 64), kargs, LDS_BYTES, stream);
    if (e != hipSuccess) fprintf(stderr, "kernel_launch: cooperative launch failed: %s (grid %d)\n", hipGetErrorString(e), grid);
#else
    for (int p = 0; p < N_PHASES; ++p) { a.ph_lo = p; a.ph_hi = p + 1; hipLaunchKernelGGL(hybrid_fwd, dim3(grid), dim3(NWAVES * 64), LDS_BYTES, stream, a); }
#endif
}
```
